# Optimizing an MI355X kernel written in HIP

```python
import math
import jax
import jax.numpy as jnp
from jax import lax
import numpy as np

D_MODEL = 1024
BATCH = 32
SEQ = 2048
DEPTH = 1

CHUNK = 64
Q_BLOCK = 128

POOL_DIM = D_MODEL // 2
POOL_WINDOWS = (2, 4, 8, 16)
POOL_GROUPS = len(POOL_WINDOWS)
POOL_GROUP_DIM = POOL_DIM // POOL_GROUPS
ATTN_HEADS = 4
ATTN_HEAD_DIM = 64
QK_DIM = ATTN_HEADS * 2 * ATTN_HEAD_DIM
V_DIM = ATTN_HEADS * 2 * ATTN_HEAD_DIM
IN_DIM = POOL_DIM + 2 * QK_DIM + V_DIM
MIX_DIM = POOL_DIM + V_DIM

NUM_BUCKETS = 32
MAX_DISTANCE = 128

N_EXPERTS = 256
TOP_K = 8
N_GROUPS = 8
TOP_K_GROUPS = 4
EXPERT_DIM = 256
SHARED_DIM = 256
ROUTED_SCALE = 2.5
DISPATCH_BLOCK = 256

ALPHA = (2.0 * DEPTH) ** 0.25
BETA = (8.0 * DEPTH) ** -0.25
LN_EPS = 1e-5

kernel_name = "hybrid_pool_diffattn_moe_deepnorm_adaln"


def layer_norm(x, g, b):
    xf = x.astype(jnp.float32)
    mu = jnp.mean(xf, axis=-1, keepdims=True)
    var = jnp.mean(jnp.square(xf - mu), axis=-1, keepdims=True)
    y = (xf - mu) * lax.rsqrt(var + LN_EPS) * g.astype(jnp.float32) + b.astype(jnp.float32)
    return y.astype(x.dtype)


def rms_norm(x, g):
    xf = x.astype(jnp.float32)
    y = xf * lax.rsqrt(jnp.mean(jnp.square(xf), axis=-1, keepdims=True) + LN_EPS)
    return (y * g.astype(jnp.float32)).astype(x.dtype)


def t5_bucket(rel):
    half = NUM_BUCKETS // 2
    max_exact = half // 2
    ret = jnp.where(rel > 0, half, 0)
    n = jnp.abs(rel)
    nf = jnp.maximum(n, 1).astype(jnp.float32)
    large = max_exact + (jnp.log(nf / max_exact) / math.log(MAX_DISTANCE / max_exact)
                         * (half - max_exact)).astype(jnp.int32)
    large = jnp.minimum(large, half - 1)
    return ret + jnp.where(n < max_exact, n, large)


def multiscale_pool(u, pool_w, pool_scale):
    B, S, _ = u.shape
    ug = u.reshape(B, S, POOL_GROUPS, POOL_GROUP_DIM).astype(jnp.float32)
    cs = jnp.cumsum(ug, axis=1)
    t = jnp.arange(1, S + 1, dtype=jnp.float32)
    outs = []
    for g, w in enumerate(POOL_WINDOWS):
        c = cs[:, :, g]
        lag = jnp.pad(c[:, :S - w], ((0, 0), (w, 0), (0, 0)))
        mean = (c - lag) / jnp.minimum(t, float(w))[None, :, None]
        outs.append(mean - ug[:, :, g])
    pooled = jnp.stack(outs, axis=2).astype(u.dtype)
    y = jnp.einsum('bsgc,gcd->bsgd', pooled, pool_w).reshape(B, S, POOL_DIM)
    return y * pool_scale


def diff_attention(q, k, v, lam, subln_g, rel_table, lambda_init):
    B, S, _ = q.shape
    q = q.reshape(B, S, ATTN_HEADS, 2, ATTN_HEAD_DIM) * (ATTN_HEAD_DIM ** -0.5)
    k = k.reshape(B, S, ATTN_HEADS, 2, ATTN_HEAD_DIM)
    v = v.reshape(B, S, ATTN_HEADS, 2 * ATTN_HEAD_DIM)
    pos = jnp.arange(S, dtype=jnp.int32)
    outs = []
    for qs in range(0, S, Q_BLOCK):
        qe = min(qs + Q_BLOCK, S)
        ke = min(S, -(-qe // CHUNK) * CHUNK)
        qp, kp = pos[qs:qe], pos[:ke]
        logits = jnp.einsum('bqhmd,bkhmd->bhmqk', q[:, qs:qe], k[:, :ke]).astype(jnp.float32)
        bias = rel_table[t5_bucket(kp[None, :] - qp[:, None])].astype(jnp.float32)
        bias = jnp.transpose(bias, (2, 0, 1))[None, :, None]
        allowed = (kp[None, :] // CHUNK) <= (qp[:, None] // CHUNK)
        logits = jnp.where(allowed, logits + bias, -jnp.inf)
        p = jax.nn.softmax(logits, axis=-1)
        pd = p[:, :, 0] - lam * p[:, :, 1]
        outs.append(jnp.einsum('bhqk,bkhe->bqhe', pd.astype(v.dtype), v[:, :ke]))
    o = jnp.concatenate(outs, axis=1)
    o = rms_norm(o, subln_g) * (1.0 - lambda_init)
    return o.reshape(B, S, V_DIM)


def route(h_flat, w_router, router_bias):
    N = h_flat.shape[0]
    scores = jax.nn.sigmoid(jnp.matmul(h_flat.astype(jnp.float32), w_router.astype(jnp.float32)))
    sel = scores + router_bias.astype(jnp.float32)
    grouped = sel.reshape(N, N_GROUPS, N_EXPERTS // N_GROUPS)
    group_score = lax.top_k(grouped, 2)[0].sum(-1)
    _, gidx = lax.top_k(group_score, TOP_K_GROUPS)
    gmask = jax.nn.one_hot(gidx, N_GROUPS, dtype=jnp.float32).sum(1) > 0
    emask = jnp.repeat(gmask, N_EXPERTS // N_GROUPS, axis=1)
    _, idx = lax.top_k(jnp.where(emask, sel, -jnp.inf), TOP_K)
    w = jnp.take_along_axis(scores, idx, axis=1)
    w = w / jnp.sum(w, axis=-1, keepdims=True) * ROUTED_SCALE
    return idx.astype(jnp.int32), w


def routed_experts(h_flat, idx, wts, w_gate, w_up, w_down):
    N, D = h_flat.shape
    A = N * TOP_K
    M = DISPATCH_BLOCK
    flat_e = idx.reshape(-1)
    flat_w = wts.reshape(-1).astype(h_flat.dtype)
    flat_tok = jnp.arange(A, dtype=jnp.int32) // TOP_K
    order = jnp.argsort(flat_e, stable=True)
    se, stok, sw = flat_e[order], flat_tok[order], flat_w[order]
    counts = jnp.bincount(flat_e, length=N_EXPERTS).astype(jnp.int32)
    starts = jnp.cumsum(counts) - counts
    padded = (counts + M - 1) // M * M
    pends = jnp.cumsum(padded)
    pstarts = pends - padded
    dest = pstarts[se] + (jnp.arange(A, dtype=jnp.int32) - starts[se])
    n_blocks = -(-(A + N_EXPERTS * (M - 1)) // M)
    P = n_blocks * M
    slot_tok = jnp.zeros((P,), jnp.int32).at[dest].set(stok)
    slot_w = jnp.zeros((P,), h_flat.dtype).at[dest].set(sw)
    block_e = jnp.minimum(jnp.searchsorted(pends, jnp.arange(n_blocks, dtype=jnp.int32) * M, side='right'),
                          N_EXPERTS - 1).astype(jnp.int32)

    def body(acc, blk):
        tok, wt, e = blk
        xs = h_flat[tok]
        a = jax.nn.silu(xs @ w_gate[e]) * (xs @ w_up[e])
        y = (a @ w_down[e]) * wt[:, None]
        return acc.at[tok].add(y), None

    acc, _ = lax.scan(body, jnp.zeros_like(h_flat),
                      (slot_tok.reshape(n_blocks, M), slot_w.reshape(n_blocks, M), block_e))
    return acc


def setup_inputs(seed: int = 0) -> dict:
    key = jax.random.key(seed)
    ks = jax.random.split(key, 26)
    f32 = jnp.float32
    L, D = DEPTH, D_MODEL
    nrm = lambda k, shape, s: jax.random.normal(k, shape, f32) * s
    w_in = nrm(ks[4], (L, D, IN_DIM), D ** -0.5)
    v_cols = jnp.arange(IN_DIM) >= POOL_DIM + 2 * QK_DIM
    w_in = w_in * jnp.where(v_cols, BETA, 1.0).astype(f32)
    return {
        "x": nrm(ks[0], (BATCH, SEQ, D), 1.0),
        "c": nrm(ks[1], (BATCH, D), 1.0),
        "w_ada": nrm(ks[2], (L, D, 6 * D), D ** -0.5),
        "b_ada": nrm(ks[3], (L, 6 * D), 0.02),
        "w_in": w_in,
        "pool_w": nrm(ks[5], (L, POOL_GROUPS, POOL_GROUP_DIM, POOL_GROUP_DIM), POOL_GROUP_DIM ** -0.5),
        "pool_scale": 1.0 + nrm(ks[6], (L, POOL_DIM), 0.02),
        "lambda_q1": nrm(ks[7], (L, ATTN_HEAD_DIM), 0.1),
        "lambda_k1": nrm(ks[8], (L, ATTN_HEAD_DIM), 0.1),
        "lambda_q2": nrm(ks[9], (L, ATTN_HEAD_DIM), 0.1),
        "lambda_k2": nrm(ks[10], (L, ATTN_HEAD_DIM), 0.1),
        "subln_g": 1.0 + nrm(ks[11], (L, 2 * ATTN_HEAD_DIM), 0.02),
        "w_out": nrm(ks[12], (L, MIX_DIM, D), MIX_DIM ** -0.5 * BETA),
        "ln1_g": 1.0 + nrm(ks[13], (L, D), 0.02),
        "ln1_b": nrm(ks[14], (L, D), 0.02),
        "w_router": nrm(ks[15], (L, D, N_EXPERTS), D ** -0.5),
        "router_bias": nrm(ks[16], (L, N_EXPERTS), 0.01),
        "w_gate": nrm(ks[17], (L, N_EXPERTS, D, EXPERT_DIM), D ** -0.5),
        "w_up": nrm(ks[18], (L, N_EXPERTS, D, EXPERT_DIM), D ** -0.5),
        "w_down": nrm(ks[19], (L, N_EXPERTS, EXPERT_DIM, D), EXPERT_DIM ** -0.5 * BETA),
        "ws_gate": nrm(ks[20], (L, D, SHARED_DIM), D ** -0.5),
        "ws_up": nrm(ks[21], (L, D, SHARED_DIM), D ** -0.5),
        "ws_down": nrm(ks[22], (L, SHARED_DIM, D), SHARED_DIM ** -0.5 * BETA),
        "ln2_g": 1.0 + nrm(ks[23], (L, D), 0.02),
        "ln2_b": nrm(ks[24], (L, D), 0.02),
        "rel_table": nrm(ks[25], (NUM_BUCKETS, ATTN_HEADS), 0.5),
    }


def reference(x, c, w_ada, b_ada, w_in, pool_w, pool_scale, lambda_q1, lambda_k1, lambda_q2, lambda_k2,
              subln_g, w_out, ln1_g, ln1_b, w_router, router_bias, w_gate, w_up, w_down,
              ws_gate, ws_up, ws_down, ln2_g, ln2_b, rel_table):
    B, S, D = x.shape
    c_act = jax.nn.silu(c)
    for l in range(DEPTH):
        mod = c_act @ w_ada[l] + b_ada[l]
        shift1, scale1, gate1, shift2, scale2, gate2 = [m[:, None, :] for m in jnp.split(mod, 6, axis=-1)]
        lambda_init = 0.8 - 0.6 * math.exp(-0.3 * l)

        h = x * (1.0 + scale1) + shift1
        proj = h @ w_in[l]
        u = proj[..., :POOL_DIM]
        q = proj[..., POOL_DIM:POOL_DIM + QK_DIM]
        k = proj[..., POOL_DIM + QK_DIM:POOL_DIM + 2 * QK_DIM]
        v = proj[..., POOL_DIM + 2 * QK_DIM:]
        lam = (jnp.exp(jnp.sum(lambda_q1[l].astype(jnp.float32) * lambda_k1[l].astype(jnp.float32)))
               - jnp.exp(jnp.sum(lambda_q2[l].astype(jnp.float32) * lambda_k2[l].astype(jnp.float32)))
               + lambda_init)
        y_pool = multiscale_pool(u, pool_w[l], pool_scale[l])
        y_attn = diff_attention(q, k, v, lam, subln_g[l], rel_table, lambda_init)
        mix = jnp.concatenate([y_pool, y_attn], axis=-1) @ w_out[l]
        x = layer_norm(ALPHA * x + gate1 * mix, ln1_g[l], ln1_b[l])

        h2 = (x * (1.0 + scale2) + shift2).reshape(B * S, D)
        idx, wts = route(h2, w_router[l], router_bias[l])
        routed = routed_experts(h2, idx, wts, w_gate[l], w_up[l], w_down[l])
        shared = (jax.nn.silu(h2 @ ws_gate[l]) * (h2 @ ws_up[l])) @ ws_down[l]
        ffn = (routed + shared).reshape(B, S, D)
        x = layer_norm(ALPHA * x + gate2 * ffn, ln2_g[l], ln2_b[l])
    return x
```

```cpp
#define MK_N_LAUNCHES 1
#include <hip/hip_runtime.h>
#include <cstdio>
#include <cstdint>

#define LAS __attribute__((address_space(3)))
#define GAS __attribute__((address_space(1)))
typedef unsigned short bf16_t;
typedef short bf16x8 __attribute__((ext_vector_type(8)));
typedef short s16x4 __attribute__((ext_vector_type(4)));
typedef float f32x2 __attribute__((ext_vector_type(2)));
typedef float f32x4 __attribute__((ext_vector_type(4)));
typedef float f32x16 __attribute__((ext_vector_type(16)));
typedef unsigned u32x2 __attribute__((ext_vector_type(2)));
typedef unsigned u32x4 __attribute__((ext_vector_type(4)));
typedef GAS unsigned gu32;
#define RLX_AGENT __ATOMIC_RELAXED, __HIP_MEMORY_SCOPE_AGENT
#define LDS_WAIT() asm volatile("s_waitcnt lgkmcnt(0)" ::: "memory")
#define VM_WAIT() asm volatile("s_waitcnt vmcnt(0)" ::: "memory")

constexpr int DM = 1024, NB = 32, SEQ = 2048, NTOK = NB * SEQ, IND = 2048, NEXP = 256, TOPK = 8, EDIM = 256;
constexpr float LN_EPS = 1e-5f;
constexpr float ALPHA = 1.189207115002721f;
constexpr float LOG2E = 1.4426950408889634f;
constexpr float QSCALE = 0.125f * LOG2E;
constexpr float LAMBDA_INIT = 0.2f;
constexpr float YSCALE = 64.f, YINV = 1.f / 64.f;
constexpr float WSCALE = 64.f, HSCALE = 4.f;
constexpr int NWAVES = 8;

constexpr size_t MiB = 1u << 20;
constexpr size_t WS_CTL = 0, CTL_ZERO_BYTES = 64 * 1024;
constexpr size_t WS_MODP = 1 * MiB;
constexpr size_t WS_MODF = 4 * MiB;
constexpr size_t WS_WIN = 5 * MiB;
constexpr size_t WS_WOUT = 9 * MiB;
constexpr size_t WS_WR = 11 * MiB;
constexpr size_t WS_WSGU = 11 * MiB + 512 * 1024;
constexpr size_t WS_WSD = 12 * MiB + 512 * 1024;
constexpr size_t WS_WPOOL = 13 * MiB;
constexpr size_t WS_AE = 14 * MiB;
constexpr size_t WS_AW = 16 * MiB;
constexpr size_t WS_AR = 18 * MiB;
constexpr size_t WS_CNT = 20 * MiB;
constexpr size_t WS_TILE_E = 20 * MiB + 512 * 1024;
constexpr size_t WS_STOK = 21 * MiB;
constexpr size_t WS_SDST = 24 * MiB;
constexpr size_t WS_SW = 27 * MiB;
constexpr size_t WS_WD = 30 * MiB;
constexpr size_t WS_X1 = 158 * MiB;
constexpr size_t WS_WGU = 286 * MiB;
constexpr size_t WS_H2F8 = 414 * MiB;
constexpr size_t WS_BUFA = 542 * MiB;
constexpr size_t WS_BUFB = 670 * MiB;
constexpr size_t WS_Y = 286 * MiB;
constexpr size_t WS_END = 862 * MiB;
static_assert(WS_Y + (size_t)589824 * 1024 <= WS_END && WS_BUFB + (size_t)NTOK * DM * 2 <= WS_END && WS_H2F8 + (size_t)NTOK * DM <= WS_BUFA, "ws map");
constexpr int CW_BAR = 1024;
constexpr int H_SHARED0 = 2304;

constexpr int RING_BYTES = 131072;
constexpr int MISC_OFF = RING_BYTES;
constexpr int LDS_BYTES = 147456;

__device__ __forceinline__ unsigned cvt_pk_bf16(float lo, float hi) { unsigned r; asm volatile("v_cvt_pk_bf16_f32 %0, %1, %2" : "=v"(r) : "v"(lo), "v"(hi)); return r; }
__device__ __forceinline__ float clamp8(float v) { return __builtin_fminf(__builtin_fmaxf(v, -448.f), 448.f); }
__device__ __forceinline__ unsigned pk4_fp8(float a, float b, float c, float d) { int p = __builtin_amdgcn_cvt_pk_fp8_f32(clamp8(a), clamp8(b), 0, false); p = __builtin_amdgcn_cvt_pk_fp8_f32(clamp8(c), clamp8(d), p, true); return (unsigned)p; }
__device__ __forceinline__ float bf_lo(unsigned u) { return __builtin_bit_cast(float, u << 16); }
__device__ __forceinline__ float bf_hi(unsigned u) { return __builtin_bit_cast(float, u & 0xffff0000u); }
__device__ __forceinline__ float wave_sum(float v) {
#pragma unroll
    for (int o = 1; o < 64; o <<= 1) v += __shfl_xor(v, o);
    return v;
}
__device__ __forceinline__ float sigmoidf_(float x) { return __builtin_amdgcn_rcpf(1.f + __expf(-x)); }
__device__ __forceinline__ float sigmoid_exact(float x) { return 1.f / (1.f + __expf(-x)); }
__device__ __forceinline__ int crow(int r, int hi) { return (r & 3) + 8 * (r >> 2) + 4 * hi; }

#define XB_TMO      128
#define XB_XCNT(j)  (256  + 64 * (j))
#define XB_XSUB(j)  (1280 + 64 * (j))
#define XB_XGEN(j)  (2304 + 64 * (j))
#define XB_TOP      3328
#define XB_TOPGEN   3392
#define XCD_BAR_WORDS 3456
#define XB_SPIN_CAP (1u << 18)

__device__ __forceinline__ unsigned xb_ld(unsigned* p)              { return __hip_atomic_load(p, __ATOMIC_RELAXED, __HIP_MEMORY_SCOPE_AGENT); }
__device__ __forceinline__ unsigned xb_add(unsigned* p, unsigned v) { return __hip_atomic_fetch_add(p, v, __ATOMIC_RELAXED, __HIP_MEMORY_SCOPE_AGENT); }
__device__ __forceinline__ unsigned xb_xcc_id() { return (unsigned)__builtin_amdgcn_s_getreg((3 << 11) | 20) & 0xFu; }
#define XB_SPIN(cond, bar) do { unsigned _sp = 0; while (cond) { __builtin_amdgcn_s_sleep(1); \
    if ((++_sp & 255u) == 0u) { if (xb_ld(&(bar)[XB_TMO])) break; if (_sp > XB_SPIN_CAP) { atomicAdd(&(bar)[XB_TMO], 1u); break; } } } } while (0)

struct XcdBarrier {
    unsigned* bar; unsigned x;
    volatile LAS unsigned* st;
};

__device__ __forceinline__ XcdBarrier xcd_barrier_post(unsigned* bar, volatile LAS unsigned* st) {
    XcdBarrier b; b.bar = bar; b.x = xb_xcc_id(); b.st = st;
    if (threadIdx.x == 0) (void)xb_add(&bar[XB_XCNT(b.x)], 1u);
    return b;
}
__device__ __forceinline__ void xcd_barrier_complete(unsigned* bar, unsigned x, unsigned& nloc, unsigned& nx) {
    const unsigned G = gridDim.x * gridDim.y * gridDim.z;
    unsigned sum, cnt, mine, sp = 0u;
    for (;;) {
        sum = 0u; cnt = 0u; mine = 0u;
#pragma unroll
        for (unsigned j = 0; j < 16; ++j) { const unsigned c = xb_ld(&bar[XB_XCNT(j)]); sum += c; cnt += (c > 0u) ? 1u : 0u; mine = (j == x) ? c : mine; }
        if (sum == G) break;
        __builtin_amdgcn_s_sleep(1);
        if ((++sp & 255u) == 0u) { if (xb_ld(&bar[XB_TMO])) break; if (sp > XB_SPIN_CAP) { atomicAdd(&bar[XB_TMO], 1u); break; } }
    }
    nloc = mine > 0u ? mine : 1u; nx = cnt > 0u ? cnt : 1u;
}

__device__ __forceinline__ void xcd_barrier(const XcdBarrier& b) {
    asm volatile("s_waitcnt vmcnt(0)" ::: "memory");
    __syncthreads();
    if (threadIdx.x == 0) {
        unsigned* bar = b.bar;
        __builtin_amdgcn_s_waitcnt(0);
        unsigned nloc = b.st[0], nx = b.st[1];
        if (nloc == 0u) { xcd_barrier_complete(bar, b.x, nloc, nx); b.st[0] = nloc; b.st[1] = nx; }
        const unsigned old = xb_add(&bar[XB_XSUB(b.x)], 1u);
        const unsigned gen = old / nloc;
        if (old + 1u == (gen + 1u) * nloc) {
            __builtin_amdgcn_fence(__ATOMIC_RELEASE, "agent");
            asm volatile("s_waitcnt vmcnt(0)" ::: "memory");
            const unsigned og = xb_add(&bar[XB_TOP], 1u);
            const unsigned tg = og / nx;
            if (og + 1u == (tg + 1u) * nx) xb_add(&bar[XB_TOPGEN], 1u);
            else XB_SPIN(xb_ld(&bar[XB_TOPGEN]) == tg, bar);
            __builtin_amdgcn_fence(__ATOMIC_ACQUIRE, "agent");
            xb_add(&bar[XB_XGEN(b.x)], 1u);
            asm volatile("s_waitcnt vmcnt(0)" ::: "memory");
        } else {
            XB_SPIN(xb_ld(&bar[XB_XGEN(b.x)]) == gen, bar);
            __builtin_amdgcn_fence(__ATOMIC_ACQUIRE, "agent");
            asm volatile("s_waitcnt vmcnt(0)" ::: "memory");
        }
    }
    __syncthreads();
}

namespace pg8 {
constexpr int BM = 256, BK = 64, HALF = 128, HTB = HALF * BK * 2, STAGE_BYTES = 8 * HTB;
__host__ __device__ __forceinline__ int lds_byte(int r, int c) { const int st = (r >> 4) * 2 + (c >> 5), rr = r & 15, cc = c & 31, ob = rr * 64 + cc * 2; return st * 1024 + (ob ^ (((ob >> 9) & 1) << 5)); }
__host__ __device__ __forceinline__ void stage_rc(int b, int& R, int& C) { const int st = b / 1024, sb = b % 1024, swz = sb ^ (((sb >> 9) & 1) << 5); R = (st >> 1) * 16 + swz / 64; C = (st & 1) * 32 + (swz % 64) / 2; }
__host__ __device__ __forceinline__ int perm32(int rho) { const int n = rho >> 4, i = rho & 15; return 8 * (i >> 2) + 4 * n + (i & 3); }

struct Unit {
    const char* A;
    const char* B;
    const int* idx;
    int row0;
    int tile, pn, kind, e;
    int slot;
    int sameA;
};
__device__ __forceinline__ void glds16m(const char* sbase, unsigned voff, unsigned lds_dst, int msk) {
    unsigned keep;
    asm volatile("s_mov_b32 %0, m0\n\ts_mov_b32 m0, %3\n\ts_mov_b32 exec_lo, %4\n\ts_mov_b32 exec_hi, %4\n\ts_nop 0\n\tglobal_load_lds_dwordx4 %1, %2\n\ts_mov_b64 exec, -1\n\ts_mov_b32 m0, %0"
                 : "=&s"(keep) : "v"(voff), "s"(sbase), "s"(lds_dst), "s"(msk) : "memory");
}

typedef int v8i32 __attribute__((ext_vector_type(8)));
template <class Epi, class Sched, bool GATHER, bool ALIGN_EPI, bool FP8 = false, bool SKIPA = false>
__device__ __forceinline__ void gemm_phase(LAS unsigned char* lds, const int K_, const Sched& S, const Epi& E) {
    int K = K_; asm volatile("" : "+s"(K));
    const int tid = threadIdx.x, wid = __builtin_amdgcn_readfirstlane(tid >> 6), lane = tid & 63, wr = wid >> 2, wc = wid & 3, fr = lane & 15, fq = lane >> 4;
    const int nt = K / BK;
    unsigned voffA[2], voffB[2];
#pragma unroll
    for (int i = 0; i < 2; ++i) { int R, C; stage_rc(tid * 16 + i * 8192, R, C); const int Rb = Epi::PERM ? ((R & ~31) + perm32(R & 31)) : R;
        voffA[i] = (unsigned)(R * K + C) * 2u; voffB[i] = (unsigned)(Rb * K + C) * 2u; }
    const size_t kstep = (size_t)(BK * 2);
    const size_t hstep = (size_t)HALF * K * 2;
    const unsigned ldsw = (unsigned)wid * 1024u, lds0 = (unsigned)(uintptr_t)lds;
    const int aoff = lds_byte(wr * 64 + fr, fq * 8), boff = lds_byte(wc * 32 + fr, fq * 8);
#define PG8_SA(b, h) (((b) * 2 + (h)) * HTB)
#define PG8_SB(b, h) ((4 + (b) * 2 + (h)) * HTB)
#define PG8_STAGE(bufoff, gbase, voff) do { _Pragma("unroll") for (int _i = 0; _i < 2; ++_i) \
        __builtin_amdgcn_global_load_lds((const unsigned*)((const char*)(gbase) + (voff)[_i]), (LAS unsigned*)(lds + (bufoff) + ldsw + _i * 8192), 16, 0, 0); } while (0)
#define PG8_STAGE_A(bufoff, p, h, OA) do { if constexpr (GATHER) { PG8_STAGE(bufoff, p, OA[h]); } else { PG8_STAGE(bufoff, (p) + (h) * hstep, voffA); } } while (0)
#define PG8_STAGE_AM(bufoff, p, h, OA, msk) do { if constexpr (SKIPA) { _Pragma("unroll") for (int _i = 0; _i < 2; ++_i) \
        glds16m((const char*)(p), OA[h][_i], (unsigned)__builtin_amdgcn_readfirstlane((int)(lds0 + (bufoff) + ldsw + _i * 8192)), __builtin_amdgcn_readfirstlane(msk)); } else { PG8_STAGE_A(bufoff, p, h, OA); } } while (0)
#define PG8_LD8(p) ({ const u32x4 lo_ = *(const LAS u32x4*)(p), hi_ = *(const LAS u32x4*)((p) + 1024); (v8i32){(int)lo_.x, (int)lo_.y, (int)lo_.z, (int)lo_.w, (int)hi_.x, (int)hi_.y, (int)hi_.z, (int)hi_.w}; })
#define PG8_LDA(dst, b, h) do { if constexpr (FP8) { _Pragma("unroll") for (int m = 0; m < 4; ++m) dst##8[m] = PG8_LD8(lds + PG8_SA(b, h) + aoff + m * 2048); } \
        else { _Pragma("unroll") for (int m = 0; m < 4; ++m) _Pragma("unroll") for (int k = 0; k < 2; ++k) dst[m][k] = *(const LAS bf16x8*)(lds + PG8_SA(b, h) + aoff + m * 2048 + k * 1024); } } while (0)
#define PG8_LDB(dst, b, h) do { if constexpr (FP8) { _Pragma("unroll") for (int n = 0; n < 2; ++n) dst##8[n] = PG8_LD8(lds + PG8_SB(b, h) + boff + n * 2048); } \
        else { _Pragma("unroll") for (int n = 0; n < 2; ++n) _Pragma("unroll") for (int k = 0; k < 2; ++k) dst[n][k] = *(const LAS bf16x8*)(lds + PG8_SB(b, h) + boff + n * 2048 + k * 1024); } } while (0)
#define PG8_MMA(ai, bj, At, Bt) do { __builtin_amdgcn_s_setprio(1); if constexpr (FP8) { _Pragma("unroll") for (int m = 0; m < 4; ++m) _Pragma("unroll") for (int n = 0; n < 2; ++n) \
            acc[ai][bj][m][n] = __builtin_amdgcn_mfma_scale_f32_16x16x128_f8f6f4(Bt##8[n], At##8[m], acc[ai][bj][m][n], 0, 0, 0, 0x7F7F7F7F, 0, 0x7F7F7F7F); } \
        else { _Pragma("unroll") for (int m = 0; m < 4; ++m) _Pragma("unroll") for (int n = 0; n < 2; ++n) _Pragma("unroll") for (int k = 0; k < 2; ++k) \
            acc[ai][bj][m][n] = __builtin_amdgcn_mfma_f32_16x16x32_bf16(Bt[n][k], At[m][k], acc[ai][bj][m][n], 0, 0, 0); } __builtin_amdgcn_s_setprio(0); } while (0)
#define PG8_WAIT_V(n) asm volatile("s_waitcnt vmcnt(" #n ")" ::: "memory")
#define PG8_WAIT_L(n) asm volatile("s_waitcnt lgkmcnt(" #n ")" ::: "memory")
#define PG8_BAR __builtin_amdgcn_s_barrier()
#define PG8_SCHED __builtin_amdgcn_sched_barrier(0)
#define PG8_ROWOFF(U, OA) do { if constexpr (GATHER) { int tl_ = tid; asm volatile("" : "+v"(tl_)); const LAS int* li_ = (const LAS int*)(lds + Sched::SIDE_OFF + (U).slot * 1024); \
        _Pragma("unroll") for (int _i = 0; _i < 2; ++_i) { int R_, C_; stage_rc(tl_ * 16 + _i * 8192, R_, C_); \
        _Pragma("unroll") for (int _h = 0; _h < 2; ++_h) { const int _r = _h * HALF + R_; const int _src = (U).idx ? li_[_r] : (U).row0 + _r; OA[_h][_i] = (unsigned)(_src * K + C_) * 2u; } } } } while (0)
    Unit cur, nxt; int ui = 0;
    if (!S.next(0, cur)) return;
    f32x4 acc[2][2][4][2];
#pragma unroll
    for (int a = 0; a < 2; ++a)
#pragma unroll
        for (int b = 0; b < 2; ++b)
#pragma unroll
            for (int m = 0; m < 4; ++m)
#pragma unroll
                for (int n = 0; n < 2; ++n) acc[a][b][m][n] = (f32x4){0.f, 0.f, 0.f, 0.f};
    bf16x8 At[4][2], B0[2][2], B1[2][2]; v8i32 At8[4], B08[2], B18[2];
    unsigned oA[2][2] = {{0u, 0u}, {0u, 0u}};
    const char* cA = cur.A; const char* cB = cur.B;
    cur.slot = 0; S.prefetch(cur, lds, wid, lane);
    if constexpr (GATHER) { asm volatile("s_waitcnt vmcnt(0)" ::: "memory"); __builtin_amdgcn_s_barrier(); asm volatile("" ::: "memory"); }
    PG8_ROWOFF(cur, oA);
    PG8_STAGE(PG8_SB(0, 0), cB, voffB); PG8_STAGE(PG8_SB(0, 1), cB + hstep, voffB); PG8_STAGE_A(PG8_SA(0, 0), cA, 0, oA); PG8_STAGE_A(PG8_SA(0, 1), cA, 1, oA);
    if (wr == 1) PG8_BAR;
    PG8_WAIT_V(2); PG8_BAR;
    PG8_STAGE(PG8_SB(1, 0), cB + kstep, voffB); PG8_STAGE_A(PG8_SA(1, 0), cA + kstep, 0, oA); PG8_STAGE(PG8_SB(1, 1), cB + hstep + kstep, voffB);
    PG8_WAIT_V(6); PG8_BAR;
    for (;;) {
        const bool has_next = S.next(ui + 1, nxt);
        if (has_next) { nxt.slot = (ui + 1) % 3; S.prefetch(nxt, lds, wid, lane); }
        const char* nA = has_next ? nxt.A : cA; const char* nB = has_next ? nxt.B : cB;
        const int cmsk = __builtin_amdgcn_readfirstlane((SKIPA && ui > 0 && cur.sameA) ? 0 : -1), nmsk = __builtin_amdgcn_readfirstlane((SKIPA && has_next && nxt.sameA) ? 0 : -1);
#pragma unroll 1
        for (int t = 0; t < nt; t += 2) {
            const bool last = (t == nt - 2);
            const char* a1 = cA + (size_t)(t + 1) * kstep;
            const char* a2 = last ? nA : cA + (size_t)(t + 2) * kstep; const char* b2 = last ? nB : cB + (size_t)(t + 2) * kstep;
            const char* a3 = a2 + kstep; const char* b3 = b2 + kstep;
            PG8_LDB(B0, 0, 0); PG8_LDB(B1, 0, 1); PG8_SCHED; PG8_LDA(At, 0, 0); PG8_STAGE_AM(PG8_SA(1, 1), a1, 1, oA, cmsk);
            if constexpr (GATHER) { if (last && has_next) { PG8_ROWOFF(nxt, oA); } }
            PG8_WAIT_V(8); PG8_WAIT_L(0); PG8_BAR; PG8_MMA(0, 0, At, B0); PG8_MMA(0, 1, At, B1); PG8_BAR; PG8_SCHED;
            PG8_LDA(At, 0, 1); PG8_STAGE(PG8_SB(0, 0), b2, voffB); PG8_STAGE(PG8_SB(0, 1), b2 + hstep, voffB); PG8_STAGE_AM(PG8_SA(0, 0), a2, 0, oA, (last ? nmsk : cmsk));
            PG8_WAIT_V(8); PG8_WAIT_L(0); PG8_BAR; PG8_MMA(1, 0, At, B0); PG8_MMA(1, 1, At, B1); PG8_BAR; PG8_SCHED;
            PG8_LDB(B0, 1, 0); PG8_LDB(B1, 1, 1); PG8_SCHED; PG8_LDA(At, 1, 0); PG8_STAGE_AM(PG8_SA(0, 1), a2, 1, oA, (last ? nmsk : cmsk));
            PG8_WAIT_V(8); PG8_WAIT_L(0); PG8_BAR; PG8_MMA(0, 0, At, B0); PG8_MMA(0, 1, At, B1); PG8_BAR; PG8_SCHED;
            PG8_LDA(At, 1, 1); PG8_STAGE(PG8_SB(1, 0), b3, voffB); PG8_STAGE(PG8_SB(1, 1), b3 + hstep, voffB); PG8_STAGE_AM(PG8_SA(1, 0), a3, 0, oA, (last ? nmsk : cmsk));
            PG8_WAIT_V(8); PG8_WAIT_L(0); PG8_BAR; PG8_MMA(1, 0, At, B0); PG8_MMA(1, 1, At, B1); PG8_BAR; PG8_SCHED;
        }
        if constexpr (ALIGN_EPI) { if (wr == 0) PG8_BAR; }
        if constexpr (!Epi::AFTER_DRAIN) E(acc, cur, wr, wc, fr, fq);
        if (!has_next) break;
#pragma unroll
        for (int a = 0; a < 2; ++a)
#pragma unroll
            for (int b = 0; b < 2; ++b)
#pragma unroll
                for (int m = 0; m < 4; ++m)
#pragma unroll
                    for (int n = 0; n < 2; ++n) acc[a][b][m][n] = (f32x4){0.f, 0.f, 0.f, 0.f};
        cur = nxt; cA = nA; cB = nB; ++ui;
        if constexpr (ALIGN_EPI) { if (wr == 1) PG8_BAR; }
    }
    PG8_WAIT_V(0);
    if constexpr (!ALIGN_EPI) { if (wr == 0) PG8_BAR; }
    PG8_BAR;
    if constexpr (Epi::AFTER_DRAIN) E.fused(acc, cur, wr, wc, fr, fq, lds);
#undef PG8_SA
#undef PG8_SB
#undef PG8_STAGE
#undef PG8_STAGE_A
#undef PG8_STAGE_AM
#undef PG8_LDA
#undef PG8_LD8
#undef PG8_LDB
#undef PG8_MMA
#undef PG8_WAIT_V
#undef PG8_WAIT_L
#undef PG8_BAR
#undef PG8_SCHED
#undef PG8_ROWOFF
}
}

using pg8::Unit;
typedef f32x4 AccT[2][2][4][2];
constexpr int DN_SIDE = MISC_OFF;
constexpr int DN_STAGE = MISC_OFF + 4096;

struct EpiDenseBf16 {
    static constexpr bool PERM = true, AFTER_DRAIN = false;
    bf16_t* O; int ldc; int slo, shi; float s; float base;
    __device__ __forceinline__ void operator()(const AccT& acc, const Unit& u, int wr, int wc, int fr, int fq) const {
        const float sc = ((u.pn >= slo && u.pn < shi) ? s : 1.f) * base;
        const int row0 = u.tile * 256 + wr * 64 + fr, col0 = u.pn * 256 + wc * 32 + 8 * fq;
#pragma unroll
        for (int ai = 0; ai < 2; ++ai)
#pragma unroll
            for (int m = 0; m < 4; ++m) { bf16_t* rowp = O + (size_t)(row0 + ai * 128 + m * 16) * ldc + col0;
#pragma unroll
                for (int bj = 0; bj < 2; ++bj) { const f32x4 v0 = acc[ai][bj][m][0] * sc, v1 = acc[ai][bj][m][1] * sc;
                    u32x4 w; w.x = cvt_pk_bf16(v0[0], v0[1]); w.y = cvt_pk_bf16(v0[2], v0[3]); w.z = cvt_pk_bf16(v1[0], v1[1]); w.w = cvt_pk_bf16(v1[2], v1[3]);
                    *(u32x4*)(rowp + bj * 128) = w; } }
    }
};
struct EpiLogits {
    static constexpr bool PERM = false, AFTER_DRAIN = false;
    float* C;
    __device__ __forceinline__ void operator()(const AccT& acc, const Unit& u, int wr, int wc, int fr, int fq) const {
        const int row0 = u.tile * 256 + wr * 64 + fr, col0 = wc * 32 + 4 * fq;
#pragma unroll
        for (int ai = 0; ai < 2; ++ai)
#pragma unroll
            for (int m = 0; m < 4; ++m) { float* rowp = C + (size_t)(row0 + ai * 128 + m * 16) * 256 + col0;
#pragma unroll
                for (int bj = 0; bj < 2; ++bj)
#pragma unroll
                    for (int n = 0; n < 2; ++n) *(f32x4*)(rowp + bj * 128 + n * 16) = acc[ai][bj][m][n]; }
    }
};
__device__ __forceinline__ char* h_tile_ptr(char* dout, char*, int hidx) { return dout + (size_t)hidx * 65536; }
struct EpiGateUp {
    static constexpr bool PERM = true, AFTER_DRAIN = false;
    char* dout; char* wsht;
    __device__ __forceinline__ void operator()(const AccT& acc, const Unit& u, int wr, int wc, int fr, int fq) const {
        unsigned char* Ht = (unsigned char*)h_tile_ptr(dout, wsht, u.tile);
        const int row0 = wr * 64 + fr, col0 = u.pn * 128 + wc * 32 + 8 * fq;
        constexpr float KE = -LOG2E / WSCALE, CI = WSCALE * WSCALE / HSCALE, LC = 10.f;
        static_assert(CI == 1024.f, "scale");
#pragma unroll
        for (int ai = 0; ai < 2; ++ai)
#pragma unroll
            for (int m = 0; m < 4; ++m) {
                float hv[8];
#pragma unroll
                for (int n = 0; n < 2; ++n)
#pragma unroll
                    for (int j = 0; j < 4; ++j) { const float ga = acc[ai][0][m][n][j], ua = acc[ai][1][m][n][j];
                        hv[n * 4 + j] = (ga * ua) * __builtin_amdgcn_rcpf(__builtin_amdgcn_exp2f(__builtin_fmaf(ga, KE, LC)) + CI); }
                u32x2 w; w.x = pk4_fp8(hv[0], hv[1], hv[2], hv[3]); w.y = pk4_fp8(hv[4], hv[5], hv[6], hv[7]);
                *(u32x2*)(Ht + (size_t)(row0 + ai * 128 + m * 16) * 256 + col0) = w; }
    }
};
template <bool SHARED> struct EpiDown {
    static constexpr bool PERM = true, AFTER_DRAIN = false;
    unsigned char* Y; bf16_t* X1; const float* modf; LAS unsigned char* lds;
    __device__ __forceinline__ void operator()(const AccT& acc, const Unit& u, int wr, int wc, int fr, int fq) const {
        asm volatile("" : "+v"(fr), "+v"(fq));
        const int r0 = wr * 64 + fr, c0 = u.pn * 256 + wc * 64 + 8 * fq;
        if constexpr (!SHARED) {
            const LAS float* wp = (const LAS float*)(lds + DN_SIDE + u.slot * 1024) + r0;
            const int lane_ = fq * 16 + fr;
            LAS unsigned char* st = lds + DN_STAGE + (wr * 4 + wc) * 1280;
            unsigned char* yb = Y + ((size_t)u.e + wr * 64 + (lane_ >> 2)) * 1024 + u.pn * 256 + wc * 64 + (lane_ & 3) * 16;
#pragma unroll
            for (int ai = 0; ai < 2; ++ai)
#pragma unroll
                for (int m = 0; m < 4; ++m) { const float w = wp[ai * 128 + m * 16] * (YSCALE / (WSCALE * HSCALE));
#pragma unroll
                    for (int bj = 0; bj < 2; ++bj) { const f32x4 v0 = acc[ai][bj][m][0] * w, v1 = acc[ai][bj][m][1] * w;
                        int p0 = __builtin_amdgcn_cvt_pk_fp8_f32(v0[0], v0[1], 0, false); p0 = __builtin_amdgcn_cvt_pk_fp8_f32(v0[2], v0[3], p0, true);
                        int p1 = __builtin_amdgcn_cvt_pk_fp8_f32(v1[0], v1[1], 0, false); p1 = __builtin_amdgcn_cvt_pk_fp8_f32(v1[2], v1[3], p1, true);
                        u32x2 pk; pk.x = (unsigned)p0; pk.y = (unsigned)p1;
                        *(LAS u32x2*)(st + fr * 80 + bj * 32 + 8 * fq) = pk; }
                    const u32x4 o = *(const LAS u32x4*)(st + (lane_ >> 2) * 80 + (lane_ & 3) * 16);
                    *(u32x4*)(yb + (size_t)(ai * 128 + m * 16) * 1024) = o; }
        } else {
            const int trow0 = u.e + r0;
            const float* g2 = modf + (size_t)(u.e >> 11) * 6144 + 5120 + c0;
#pragma unroll
            for (int bj = 0; bj < 2; ++bj) {
                const f32x4 ga = *(const f32x4*)(g2 + bj * 32) * (1.f / (WSCALE * HSCALE)), gb = *(const f32x4*)(g2 + bj * 32 + 4) * (1.f / (WSCALE * HSCALE));
#pragma unroll
                for (int ai = 0; ai < 2; ++ai)
#pragma unroll
                    for (int m = 0; m < 4; ++m) { bf16_t* p = X1 + (size_t)(trow0 + ai * 128 + m * 16) * DM + c0 + bj * 32;
                        const u32x4 o = *(const u32x4*)p; const f32x4 v0 = acc[ai][bj][m][0], v1 = acc[ai][bj][m][1];
                        u32x4 w;
                        w.x = cvt_pk_bf16(bf_lo(o.x) + ga[0] * v0[0], bf_hi(o.x) + ga[1] * v0[1]); w.y = cvt_pk_bf16(bf_lo(o.y) + ga[2] * v0[2], bf_hi(o.y) + ga[3] * v0[3]);
                        w.z = cvt_pk_bf16(bf_lo(o.z) + gb[0] * v1[0], bf_hi(o.z) + gb[1] * v1[1]); w.w = cvt_pk_bf16(bf_lo(o.w) + gb[2] * v1[2], bf_hi(o.w) + gb[3] * v1[3]);
                        *(u32x4*)p = w; } }
        }
    }
};

struct DenseOrder {
    static constexpr int SIDE_OFF = MISC_OFF;
    const char* A; const char* Bt; int nM, nN, nwg, G, c; size_t tstep; int ioff = 0, imax = 1 << 30; int gmode = 0;
    __device__ __forceinline__ void prefetch(const Unit&, LAS unsigned char*, int, int) const {}
    __device__ __forceinline__ void init(const void* A_, const void* Bt_, int M, int N, int K, int G_, int c_) { A = (const char*)A_; Bt = (const char*)Bt_; nM = M / 256; nN = N / 256; nwg = nM * nN; G = G_; c = c_; tstep = (size_t)256 * K * 2; }
    __device__ __forceinline__ bool next(int i, Unit& u) const {
        if (i >= imax) return false;
        const long L = (long)(i + ioff) * G + c; if (L >= nwg) return false;
        int wgid = (int)L; { const int q = nwg / 8, r = nwg % 8, xcd = wgid % 8, off = wgid / 8; wgid = (xcd < r ? xcd * (q + 1) : r * (q + 1) + (xcd - r) * q) + off; }
        const int nig = 8 * nN, gid = wgid / nig, fm = gid * 8, gsz = (nM - fm) < 8 ? (nM - fm) : 8;
        const int pm = fm + ((wgid % nig) % gsz), pn = (wgid % nig) / gsz;
        u.A = gmode ? A : A + (size_t)pm * tstep; u.B = Bt + (size_t)pn * tstep; u.idx = nullptr; u.row0 = gmode ? pm * 256 : 0; u.tile = pm; u.pn = pn; u.kind = 0; u.e = 0; return true;
    }
};
struct OneUnit {
    static constexpr int SIDE_OFF = MISC_OFF;
    const char* A; const char* Bt; int pm;
    __device__ __forceinline__ void prefetch(const Unit&, LAS unsigned char*, int, int) const {}
    __device__ __forceinline__ bool next(int i, Unit& u) const {
        if (i > 0) return false;
        u.A = A + (size_t)pm * 256 * DM * 2; u.B = Bt; u.idx = nullptr; u.row0 = 0; u.tile = pm; u.pn = 0; u.kind = 0; u.e = 0; return true;
    }
};
typedef const __attribute__((address_space(4))) int* cint_p;
struct GateUpOrder {
    static constexpr int SIDE_OFF = MISC_OFF;
    const char* h2; const char* wgu; const char* wsgu; const int* stok; const int* tile_e; int T, G, vcu;
    __device__ __forceinline__ void prefetch(const Unit& u, LAS unsigned char* lds, int wid, int lane) const {
        if (wid == 0 && u.idx) __builtin_amdgcn_global_load_lds((const unsigned*)(u.idx + lane * 4), (LAS unsigned*)(lds + SIDE_OFF + u.slot * 1024), 16, 0, 0);
    }
    __device__ __forceinline__ bool next(int i, Unit& u) const {
        const int v = i * G + vcu; if (v >= 2 * (T + 256)) return false;
        const int tile = v >> 1, half = v & 1;
        u.A = h2; u.pn = half; u.kind = 0; u.row0 = 0;
        if (tile < T) { const int e = ((cint_p)tile_e)[tile]; u.e = e; u.B = wgu + ((size_t)e * 512 + half * 256) * DM; u.idx = stok + (size_t)tile * 256; u.tile = tile; }
        else { const int j = tile - T; u.e = 0; u.B = wsgu + (size_t)half * 256 * DM; u.idx = nullptr; u.row0 = j * 256; u.tile = H_SHARED0 + j; }
        return true;
    }
};
struct DownOrder {
    static constexpr int SIDE_OFF = MISC_OFF;
    char* dout; char* wsht; const char* wd; const char* wsd; const int* tile_e; const int* sdst; const float* sw; int T, G, vcu; int shared;
    __device__ __forceinline__ void prefetch(const Unit& u, LAS unsigned char* lds, int wid, int lane) const {
        if (wid == 0 && u.kind == 0) {
            __builtin_amdgcn_global_load_lds((const unsigned*)(sw + (size_t)u.e + lane * 4), (LAS unsigned*)(lds + DN_SIDE + u.slot * 1024), 16, 0, 0);
        }
    }
    int nx, j, lo, R, rem, q0, q1;
    __device__ __forceinline__ void plan() {
        const int NT = shared ? 256 : T; nx = G >> 3; const int x = vcu / nx; j = vcu - x * nx;
        lo = (x * NT) >> 3; const int n = (((x + 1) * NT) >> 3) - lo; R = n / nx; rem = n - R * nx; q0 = (j * 4 * rem) / nx; q1 = ((j + 1) * 4 * rem) / nx;
    }
    __device__ __forceinline__ bool next(int i, Unit& u) const {
        int tl, pn, same;
        if (i < 4 * R) { tl = lo + j + nx * (i >> 2); pn = i & 3; same = pn != 0; }
        else { const int k = i - 4 * R, q = q0 + k; if (q >= q1) return false; tl = lo + nx * R + (q >> 2); pn = q & 3; same = (k > 0) && (pn != 0); }
        const int tile = tl + (shared ? T : 0);
        u.idx = nullptr; u.pn = pn; u.A = dout; u.sameA = same;
        if (tile < T) { const int e = ((cint_p)tile_e)[tile]; u.kind = 0; u.tile = tile; u.row0 = tile * 256; u.e = tile * 256; u.B = wd + ((size_t)e * 1024 + pn * 256) * EDIM; }
        else { const int j = tile - T; u.kind = 1; u.tile = H_SHARED0 + j; u.row0 = (H_SHARED0 + j) * 256; u.e = j * 256; u.B = wsd + (size_t)pn * 256 * EDIM; }
        return true;
    }
};

__device__ __forceinline__ void p0_mod_item(const float* c, const float* w_ada, float* modp, int item, int lane) {
    const int cb = item >> 2, kc = item & 3, r = lane & 31, hh = lane >> 5;
    f32x16 acc;
#pragma unroll
    for (int i = 0; i < 16; ++i) acc[i] = 0.f;
    const float* wp = w_ada + (size_t)(kc * 256 + hh) * 6144 + cb * 32 + r;
    const float* cp = c + (size_t)r * DM + kc * 256 + hh;
#pragma unroll 8
    for (int s = 0; s < 128; ++s) {
        const float a = wp[(size_t)(2 * s) * 6144];
        const float cv = cp[2 * s];
        const float b = cv * sigmoid_exact(cv);
        acc = __builtin_amdgcn_mfma_f32_32x32x2f32(a, b, acc, 0, 0, 0);
    }
    float* op = modp + ((size_t)kc * NB + r) * 6144 + cb * 32;
#pragma unroll
    for (int g = 0; g < 4; ++g) *(f32x4*)(op + 8 * g + 4 * hh) = (f32x4){acc[4 * g], acc[4 * g + 1], acc[4 * g + 2], acc[4 * g + 3]};
}
__device__ __forceinline__ void p0_tr_tile(const float* W, int N, int k0, int n0, bf16_t* WT, int ldt, int drow0, LAS unsigned char* scr, int lane, int hi_off = 0) {
    const int g = lane >> 4, nl = lane & 15;
    const float* src = W + (size_t)(k0 + 16 * g) * N + n0 + 4 * nl;
    f32x4 v[16];
#pragma unroll
    for (int i = 0; i < 16; ++i) v[i] = *(const f32x4*)(src + (size_t)i * N);
#pragma unroll
    for (int j = 0; j < 4; ++j) {
        u32x4 lo, hi;
        lo.x = cvt_pk_bf16(v[0][j], v[1][j]); lo.y = cvt_pk_bf16(v[2][j], v[3][j]); lo.z = cvt_pk_bf16(v[4][j], v[5][j]); lo.w = cvt_pk_bf16(v[6][j], v[7][j]);
        hi.x = cvt_pk_bf16(v[8][j], v[9][j]); hi.y = cvt_pk_bf16(v[10][j], v[11][j]); hi.z = cvt_pk_bf16(v[12][j], v[13][j]); hi.w = cvt_pk_bf16(v[14][j], v[15][j]);
        LAS unsigned char* p = scr + (4 * nl + j) * 144 + 32 * g;
        *(LAS u32x4*)p = lo; *(LAS u32x4*)(p + 16) = hi;
    }
    LDS_WAIT(); asm volatile("" ::: "memory");
#pragma unroll
    for (int i = 0; i < 8; ++i) { const int row = (lane >> 3) + 8 * i, ch = lane & 7;
        const u32x4 o = *(const LAS u32x4*)(scr + row * 144 + ch * 16);
        *(u32x4*)(WT + (size_t)(drow0 + row + (row >= 32 ? hi_off : 0)) * ldt + k0 + ch * 8) = o; }
    LDS_WAIT(); asm volatile("" ::: "memory");
}
__device__ __forceinline__ void p0_tr_tile8(const float* W, int N, int k0, int n0, unsigned char* WT, int ldt, int drow0, LAS unsigned char* scr, int lane, int hi_off = 0) {
    const int g = lane >> 4, nl = lane & 15;
    const float* src = W + (size_t)(k0 + 32 * g) * N + n0 + 4 * nl;
    f32x4 v[32];
#pragma unroll
    for (int i = 0; i < 32; ++i) v[i] = *(const f32x4*)(src + (size_t)i * N);
#pragma unroll
    for (int j = 0; j < 4; ++j) {
        u32x4 o0, o1;
        o0.x = pk4_fp8(v[0][j] * WSCALE, v[1][j] * WSCALE, v[2][j] * WSCALE, v[3][j] * WSCALE); o0.y = pk4_fp8(v[4][j] * WSCALE, v[5][j] * WSCALE, v[6][j] * WSCALE, v[7][j] * WSCALE);
        o0.z = pk4_fp8(v[8][j] * WSCALE, v[9][j] * WSCALE, v[10][j] * WSCALE, v[11][j] * WSCALE); o0.w = pk4_fp8(v[12][j] * WSCALE, v[13][j] * WSCALE, v[14][j] * WSCALE, v[15][j] * WSCALE);
        o1.x = pk4_fp8(v[16][j] * WSCALE, v[17][j] * WSCALE, v[18][j] * WSCALE, v[19][j] * WSCALE); o1.y = pk4_fp8(v[20][j] * WSCALE, v[21][j] * WSCALE, v[22][j] * WSCALE, v[23][j] * WSCALE);
        o1.z = pk4_fp8(v[24][j] * WSCALE, v[25][j] * WSCALE, v[26][j] * WSCALE, v[27][j] * WSCALE); o1.w = pk4_fp8(v[28][j] * WSCALE, v[29][j] * WSCALE, v[30][j] * WSCALE, v[31][j] * WSCALE);
        LAS unsigned char* p = scr + (4 * nl + j) * 144 + 32 * g;
        *(LAS u32x4*)p = o0; *(LAS u32x4*)(p + 16) = o1;
    }
    LDS_WAIT(); asm volatile("" ::: "memory");
#pragma unroll
    for (int i = 0; i < 8; ++i) { const int row = (lane >> 3) + 8 * i, ch = lane & 7;
        const u32x4 o = *(const LAS u32x4*)(scr + row * 144 + ch * 16);
        *(u32x4*)(WT + (size_t)(drow0 + row + (row >= 32 ? hi_off : 0)) * ldt + k0 + ch * 16) = o; }
    LDS_WAIT(); asm volatile("" ::: "memory");
}
constexpr int P0_N_MOD = 768, P0_N_SMALL = 512 + 256 + 64 + 32 + 32 + 32 + 16, P0_N_EXP = 96 * NEXP;
struct TileDesc { const float* src; unsigned char* dst; int N, ldt, hi_off; };
__device__ __forceinline__ TileDesc p0_expert_tile(const float* w_gate, const float* w_up, const float* w_down, unsigned char* ws, int item, int lane) {
    const int e = item / 96, q = item % 96, g = lane >> 4, nl = lane & 15;
    TileDesc d;
    if (q < 64) { const int qq = q & 31, n0 = 64 * (qq & 3), k0 = 128 * (qq >> 2); const float* W = (q < 32 ? w_gate : w_up) + (size_t)e * DM * EDIM;
        d.N = EDIM; d.ldt = DM; d.hi_off = 0; d.src = W + (size_t)(k0 + 16 * g) * EDIM + n0 + 4 * nl;
        d.dst = ws + WS_WGU + ((size_t)e * 512 + (n0 >> 7) * 256 + (q < 32 ? 0 : 128) + (n0 & 127)) * DM + k0; }
    else { const int qq = q - 64, n0 = 64 * (qq & 15), k0 = 128 * (qq >> 4); const float* W = w_down + (size_t)e * EDIM * DM;
        d.N = DM; d.ldt = EDIM; d.hi_off = 96; d.src = W + (size_t)(k0 + 16 * g) * DM + n0 + 4 * nl;
        d.dst = ws + WS_WD + ((size_t)e * DM + (n0 & ~255) + 32 * ((n0 & 255) >> 6)) * EDIM + k0; }
    return d;
}
#define P0_LOAD_HALF(v, d, half) do { _Pragma("unroll") for (int i_ = 0; i_ < 16; ++i_) v[i_] = *(const f32x4*)((d).src + (size_t)((half) * 64 + i_) * (d).N); } while (0)
#define P0_CVT_HALF(v, half) do { _Pragma("unroll") for (int j_ = 0; j_ < 4; ++j_) { u32x4 o_; \
        o_.x = pk4_fp8(v[0][j_] * WSCALE, v[1][j_] * WSCALE, v[2][j_] * WSCALE, v[3][j_] * WSCALE); o_.y = pk4_fp8(v[4][j_] * WSCALE, v[5][j_] * WSCALE, v[6][j_] * WSCALE, v[7][j_] * WSCALE); \
        o_.z = pk4_fp8(v[8][j_] * WSCALE, v[9][j_] * WSCALE, v[10][j_] * WSCALE, v[11][j_] * WSCALE); o_.w = pk4_fp8(v[12][j_] * WSCALE, v[13][j_] * WSCALE, v[14][j_] * WSCALE, v[15][j_] * WSCALE); \
        *(LAS u32x4*)(scr + (4 * nl + j_) * 144 + (half) * 64 + 16 * g) = o_; } } while (0)
__device__ __forceinline__ void p0_expert_stream(const float* w_gate, const float* w_up, const float* w_down, unsigned char* ws, LAS unsigned char* lds, int gw, int NGW, int wave, int lane, int it_lo, int it_hi) {
    LAS unsigned char* scr = lds + wave * 9216;
    const int g = lane >> 4, nl = lane & 15;
    int it = it_lo + gw;
    if (it >= it_hi) return;
    TileDesc cur = p0_expert_tile(w_gate, w_up, w_down, ws, it, lane);
    f32x4 va[16], vb[16];
    P0_LOAD_HALF(va, cur, 0); P0_LOAD_HALF(vb, cur, 1);
    for (;;) {
        const int nit = it + NGW; const bool more = nit < it_hi;
        TileDesc nxt = cur; if (more) nxt = p0_expert_tile(w_gate, w_up, w_down, ws, nit, lane);
        P0_CVT_HALF(va, 0);
        if (more) P0_LOAD_HALF(va, nxt, 0);
        P0_CVT_HALF(vb, 1);
        if (more) P0_LOAD_HALF(vb, nxt, 1);
        LDS_WAIT(); asm volatile("" ::: "memory");
#pragma unroll
        for (int i = 0; i < 8; ++i) { const int row = (lane >> 3) + 8 * i, ch = lane & 7;
            const u32x4 o = *(const LAS u32x4*)(scr + row * 144 + ch * 16);
            *(u32x4*)(cur.dst + (size_t)(row + (row >= 32 ? cur.hi_off : 0)) * cur.ldt + ch * 16) = o; }
        LDS_WAIT(); asm volatile("" ::: "memory");
        if (!more) break;
        cur = nxt; it = nit;
    }
}
#undef P0_LOAD_HALF
#undef P0_CVT_HALF
struct P0Ptrs { const float *c, *w_ada, *w_in, *w_out, *w_router, *ws_gate, *ws_up, *ws_down, *pool_w, *w_gate, *w_up, *w_down; unsigned char* ws; };
__device__ __forceinline__ void p0_phase(const P0Ptrs& P, LAS unsigned char* lds, int gw, int NGW, int wave, int lane) {
    LAS unsigned char* scr = lds + wave * 9216;
    unsigned char* ws = P.ws;
    constexpr int N_MOD = P0_N_MOD;
    for (int it = gw; it < P0_N_MOD + P0_N_SMALL; it += NGW) {
        int r = it;
        if (r < N_MOD) { p0_mod_item(P.c, P.w_ada, (float*)(ws + WS_MODP), r, lane); continue; } r -= N_MOD;
        if (r < 512) { if (r < 256) p0_tr_tile8(P.w_in, IND, 128 * (r >> 5), 64 * (r & 31), ws + WS_WIN, DM, 64 * (r & 31), scr, lane); continue; } r -= 512;
        if (r < 256) { if (r < 128) p0_tr_tile8(P.w_out, DM, 128 * (r >> 4), 64 * (r & 15), ws + WS_WOUT, DM, 64 * (r & 15), scr, lane); continue; } r -= 256;
        if (r < 64) { p0_tr_tile(P.w_router, NEXP, 64 * (r >> 2), 64 * (r & 3), (bf16_t*)(ws + WS_WR), DM, 64 * (r & 3), scr, lane); continue; } r -= 64;
        if (r < 32) { const int n0 = 64 * (r & 3); p0_tr_tile8(P.ws_gate, EDIM, 128 * (r >> 2), n0, ws + WS_WSGU, DM, (n0 >> 7) * 256 + (n0 & 127), scr, lane); continue; } r -= 32;
        if (r < 32) { const int n0 = 64 * (r & 3); p0_tr_tile8(P.ws_up, EDIM, 128 * (r >> 2), n0, ws + WS_WSGU, DM, (n0 >> 7) * 256 + 128 + (n0 & 127), scr, lane); continue; } r -= 32;
        if (r < 32) { const int n0 = 64 * (r & 15); p0_tr_tile8(P.ws_down, DM, 128 * (r >> 4), n0, ws + WS_WSD, EDIM, (n0 & ~255) + 32 * ((n0 & 255) >> 6), scr, lane, 96); continue; } r -= 32;
        if (r < 16) { const int g = r >> 2, q = r & 3; p0_tr_tile(P.pool_w + (size_t)g * 128 * 128, 128, 64 * (q >> 1), 64 * (q & 1), (bf16_t*)(ws + WS_WPOOL) + (size_t)g * 128 * 128, 128, 64 * (q & 1), scr, lane); continue; } r -= 16;
        const int e = r / 96, q = r % 96;
        if (q < 32) { const int n0 = 64 * (q & 3); p0_tr_tile8(P.w_gate + (size_t)e * DM * EDIM, EDIM, 128 * (q >> 2), n0, ws + WS_WGU + (size_t)e * 512 * DM, DM, (n0 >> 7) * 256 + (n0 & 127), scr, lane); }
        else if (q < 64) { const int qq = q - 32, n0 = 64 * (qq & 3); p0_tr_tile8(P.w_up + (size_t)e * DM * EDIM, EDIM, 128 * (qq >> 2), n0, ws + WS_WGU + (size_t)e * 512 * DM, DM, (n0 >> 7) * 256 + 128 + (n0 & 127), scr, lane); }
        else { const int qq = q - 64, n0 = 64 * (qq & 15); p0_tr_tile8(P.w_down + (size_t)e * EDIM * DM, DM, 128 * (qq >> 4), n0, ws + WS_WD + (size_t)e * DM * EDIM, EDIM, (n0 & ~255) + 32 * ((n0 & 255) >> 6), scr, lane, 96); }
    }
}

__device__ __forceinline__ float mod_sum(const float* modp, const float* b_ada, int b, int col) {
    const float* p = modp + (size_t)b * 6144 + col;
    return b_ada[col] + ((p[0] + p[(size_t)NB * 6144]) + (p[(size_t)2 * NB * 6144] + p[(size_t)3 * NB * 6144]));
}
__device__ __forceinline__ void p1_phase(const float* x, const float* b_ada, unsigned char* ws, int gw, int NGW, int lane, int gtid, int ngt) {
    const float* modp = (const float*)(ws + WS_MODP); float* modf = (float*)(ws + WS_MODF); unsigned char* h1 = ws + WS_BUFA;
    for (int i = gtid; i < NB * 6144; i += ngt) modf[i] = mod_sum(modp, b_ada, i / 6144, i % 6144);
    for (int blk = gw; blk < NTOK / 32; blk += NGW) {
        const int row0 = blk * 32, b = row0 >> 11;
        asm volatile("" : "+v"(lane));
        f32x4 sc[4], sh[4];
#pragma unroll
        for (int w = 0; w < 4; ++w) {
            const int col = 256 * w + 4 * lane; const float* p = modp + (size_t)b * 6144 + col; constexpr size_t PS = (size_t)NB * 6144;
            sh[w] = *(const f32x4*)(b_ada + col) + ((*(const f32x4*)p + *(const f32x4*)(p + PS)) + (*(const f32x4*)(p + 2 * PS) + *(const f32x4*)(p + 3 * PS)));
            sc[w] = 1.f + (*(const f32x4*)(b_ada + 1024 + col) + ((*(const f32x4*)(p + 1024) + *(const f32x4*)(p + 1024 + PS)) + (*(const f32x4*)(p + 1024 + 2 * PS) + *(const f32x4*)(p + 1024 + 3 * PS)))); }
        const float* xp = x + (size_t)row0 * DM + 4 * lane; unsigned char* hp = h1 + (size_t)row0 * DM + 4 * lane;
        f32x4 b0[16], b1[16];
#define P1_LOAD(dst, src) do { _Pragma("unroll") for (int i = 0; i < 16; ++i) dst[i] = *(const f32x4*)((src) + (size_t)(i >> 2) * DM + 256 * (i & 3)); } while (0)
#define P1_PUT(srcv, dstp) do { _Pragma("unroll") for (int i = 0; i < 16; ++i) { const int w = i & 3; const f32x4 a = srcv[i]; \
            *(unsigned*)((dstp) + (size_t)(i >> 2) * DM + 256 * w) = pk4_fp8(a[0] * sc[w][0] + sh[w][0], a[1] * sc[w][1] + sh[w][1], a[2] * sc[w][2] + sh[w][2], a[3] * sc[w][3] + sh[w][3]); } } while (0)
        P1_LOAD(b0, xp);
#pragma unroll 1
        for (int gp = 0; gp < 4; ++gp) {
            P1_LOAD(b1, xp + 4 * DM);
            __builtin_amdgcn_sched_barrier(0); P1_PUT(b0, hp); __builtin_amdgcn_sched_barrier(0);
            if (gp < 3) P1_LOAD(b0, xp + 8 * DM);
            __builtin_amdgcn_sched_barrier(0); P1_PUT(b1, hp + 4 * DM); __builtin_amdgcn_sched_barrier(0);
            xp += 8 * DM; hp += 8 * DM;
        }
#undef P1_LOAD
#undef P1_PUT
    }
}

constexpr int PL_U = 0, PL_P = 36864, PL_W = 71680, PL_PITCH = 272;
__device__ __forceinline__ void pool_load_w(const bf16_t* wpool, int g, LAS unsigned char* lds, int tid) {
    const bf16_t* src = wpool + (size_t)g * 128 * 128;
    for (int i = tid; i < 128 * 16; i += 512) { const int d = i >> 4, ch = i & 15; *(LAS u32x4*)(lds + PL_W + d * PL_PITCH + ch * 16) = *(const u32x4*)(src + d * 128 + ch * 8); }
}
__device__ __forceinline__ void pool_unit(const bf16_t* proj, bf16_t* mixin, const float* pool_scale, int ht, int g, LAS unsigned char* lds, int tid, int wave, int lane) {
    const int t0 = ht * 128, s0 = t0 & (SEQ - 1), w = 2 << g;
    for (int i = tid; i < 143 * 16; i += 512) { const int j = i >> 4, ch = i & 15; const int s = s0 - 15 + j;
        u32x4 v = (u32x4){0u, 0u, 0u, 0u};
        if (s >= 0) v = *(const u32x4*)(proj + (size_t)(t0 - 15 + j) * IND + g * 128 + ch * 8);
        *(LAS u32x4*)(lds + PL_U + j * 256 + ch * 16) = v; }
    __syncthreads();
    {
        const int c = tid & 127, seg = tid >> 7, r0 = seg * 32;
        const LAS bf16_t* Uc = (const LAS bf16_t*)(lds + PL_U) + c;
        float sum = 0.f;
        for (int j = 1; j < w; ++j) sum += bf_lo((unsigned)Uc[(r0 + 15 - j) * 128]);
        for (int r = r0; r < r0 + 32; ++r) {
            const float cur = bf_lo((unsigned)Uc[(r + 15) * 128]);
            sum += cur;
            const int s = s0 + r; const float cnt = (float)((s + 1 < w) ? (s + 1) : w);
            const float pooled = sum / cnt - cur;
            *(LAS bf16_t*)(lds + PL_P + r * PL_PITCH + c * 2) = (bf16_t)(cvt_pk_bf16(pooled, 0.f) & 0xffffu);
            sum -= bf_lo((unsigned)Uc[(r + 15 - (w - 1)) * 128]);
        }
    }
    __syncthreads();
    {
        const int rb = wave & 3, dh = wave >> 2, r = lane & 31, hh = lane >> 5;
        f32x16 acc[2];
#pragma unroll
        for (int q = 0; q < 2; ++q)
#pragma unroll
            for (int i = 0; i < 16; ++i) acc[q][i] = 0.f;
#pragma unroll
        for (int s = 0; s < 8; ++s) {
            const bf16x8 pb = *(const LAS bf16x8*)(lds + PL_P + (rb * 32 + r) * PL_PITCH + (16 * s + 8 * hh) * 2);
#pragma unroll
            for (int q = 0; q < 2; ++q) { const bf16x8 wa = *(const LAS bf16x8*)(lds + PL_W + (dh * 64 + q * 32 + r) * PL_PITCH + (16 * s + 8 * hh) * 2);
                acc[q] = __builtin_amdgcn_mfma_f32_32x32x16_bf16(wa, pb, acc[q], 0, 0, 0); }
        }
        unsigned char* op = (unsigned char*)mixin + (size_t)(t0 + rb * 32 + r) * DM + g * 128 + dh * 64;
        const float* ps = pool_scale + g * 128 + dh * 64;
#pragma unroll
        for (int q = 0; q < 2; ++q)
#pragma unroll
            for (int a = 0; a < 4; ++a) { const int d = q * 32 + 8 * a + 4 * hh; const f32x4 sc = *(const f32x4*)(ps + d);
                *(unsigned*)(op + d) = pk4_fp8(acc[q][4 * a] * sc[0], acc[q][4 * a + 1] * sc[1], acc[q][4 * a + 2] * sc[2], acc[q][4 * a + 3] * sc[3]); }
    }
    __syncthreads();
}

constexpr int AT_K = 0, AT_V = 32768, AT_Q = 65536, AT_BT = MISC_OFF, AT_BT0 = 184;
typedef float f32x8v __attribute__((ext_vector_type(8)));
constexpr int AT_LAM = MISC_OFF + 1008;
constexpr float AT_THR = 8.f;
__device__ __forceinline__ float max3v(float a, float b, float c) { float r; asm volatile("v_max3_f32 %0, %1, %2, %3" : "=v"(r) : "v"(a), "v"(b), "v"(c)); return r; }
__device__ __forceinline__ void glds16s(const char* sbase, unsigned voff, unsigned lds_dst) {
    unsigned keep;
    asm volatile("s_mov_b32 %0, m0\n\ts_mov_b32 m0, %3\n\ts_nop 0\n\tglobal_load_lds_dwordx4 %1, %2\n\ts_mov_b32 m0, %0" : "=&s"(keep) : "v"(voff), "s"(sbase), "s"(lds_dst) : "memory");
}
__device__ __forceinline__ void attn_unit(const bf16_t* proj, bf16_t* mixin, const float* rel_table, const float* subln_g, float lam, int b, int h, int qb,
                                          LAS unsigned char* lds, int tid, int wave, int lane) {
    asm volatile("" : "+v"(lane), "+v"(tid));
    const int r = lane & 31, hh = lane >> 5;
    const int rowbase = b * SEQ, q0w = 256 * qb + 32 * wave, cw = 4 * qb + (wave >> 1), NT = 4 * qb + 4;
    if (tid < 248) { const int rel = tid - AT_BT0, n = rel < 0 ? -rel : rel; int v;
        if (n < 8) v = n; else v = 8 + (n >= 12) + (n >= 16) + (n >= 23) + (n >= 32) + (n >= 46) + (n >= 64) + (n >= 91);
        const int bucket = (rel > 0 ? 16 : 0) + v;
        ((LAS float*)(lds + AT_BT))[tid] = (rel_table[bucket * 4 + h] - rel_table[15 * 4 + h]) * LOG2E; }
    LAS unsigned char* Qw = lds + AT_Q + wave * 8192 + hh * 512 + r * 16;
    { const bf16_t* qp = proj + (size_t)(rowbase + q0w + r) * IND + 512 + h * 128 + hh * 8;
#pragma unroll
      for (int m = 0; m < 2; ++m)
#pragma unroll
          for (int s = 0; s < 4; ++s) *(LAS bf16x8*)(Qw + (m * 4 + s) * 1024) = *(const bf16x8*)(qp + m * 64 + s * 16); }
    const int vp0 = 2 * wave, vp1 = 2 * wave + 1;
    const char* kbase = (const char*)proj + ((size_t)(rowbase + 8 * wave) * IND + 1024 + h * 128) * 2;
    const char* vbase0 = (const char*)proj + ((size_t)(rowbase + 16 * (vp0 & 3)) * IND + 1536 + h * 128 + 32 * (vp0 >> 2)) * 2;
    const char* vbase1 = (const char*)proj + ((size_t)(rowbase + 16 * (vp1 & 3)) * IND + 1536 + h * 128 + 32 * (vp1 >> 2)) * 2;
    const unsigned lds0 = (unsigned)(uintptr_t)lds;
#define AT_DMA_K(t, buf) do { int ln_ = lane; asm volatile("" : "+v"(ln_)); \
        const unsigned lk_ = (unsigned)(ln_ >> 4) * (IND * 2) + (unsigned)(((ln_ & 15) ^ ((8 * wave + (ln_ >> 4)) & 15)) * 16), lk2_ = (unsigned)(4 + (ln_ >> 4)) * (IND * 2) + (unsigned)(((ln_ & 15) ^ ((8 * wave + 4 + (ln_ >> 4)) & 15)) * 16); \
        const char* _b = kbase + (size_t)(t) * 64 * IND * 2; const unsigned _d = (unsigned)__builtin_amdgcn_readfirstlane((int)(lds0 + AT_K + (buf) * 16384 + (2 * wave) * 1024)); \
        glds16s(_b, lk_, _d); glds16s(_b, lk2_, _d + 1024u); } while (0)
#define AT_DMA_V(t, buf) do { int ln_ = lane; asm volatile("" : "+v"(ln_)); const unsigned lv_ = (unsigned)(ln_ >> 2) * (IND * 2) + (unsigned)(ln_ & 3) * 16u; \
        const size_t _o = (size_t)(t) * 64 * IND * 2; const unsigned _d = (unsigned)__builtin_amdgcn_readfirstlane((int)(lds0 + AT_V + (buf) * 16384)); \
        glds16s(vbase0 + _o, lv_, _d + (unsigned)(vp0 * 1024)); glds16s(vbase1 + _o, lv_, _d + (unsigned)(vp1 * 1024)); } while (0)
    f32x16 O[2][4];
#pragma unroll
    for (int m = 0; m < 2; ++m)
#pragma unroll
        for (int d = 0; d < 4; ++d)
#pragma unroll
            for (int i = 0; i < 16; ++i) O[m][d][i] = 0.f;
    float mrun[2] = {0.f, 0.f}, lrun[2] = {0.f, 0.f};
    const int kfo = r * 256 + (((r & 15) ^ hh) << 4);
    const int vfo = ((lane >> 4) & 1) * 32 + (lane & 3) * 8 + (4 * hh + ((lane & 15) >> 2)) * 64;
    f32x16 sA, sB; bf16x8 pf[4];
#pragma unroll
    for (int i = 0; i < 16; ++i) { sA[i] = 0.f; sB[i] = 0.f; }
#pragma unroll
    for (int k = 0; k < 4; ++k) pf[k] = (bf16x8){0, 0, 0, 0, 0, 0, 0, 0};
#define AT_VLD(dst, Vb, ks) do { _Pragma("unroll") for (int d_ = 0; d_ < 4; ++d_) { const LAS unsigned char* vp_ = (Vb) + (d_ * 4 + (ks)) * 1024 + vfo; \
            const s16x4 lo_ = __builtin_bit_cast(s16x4, __builtin_amdgcn_ds_read_tr16_b64_v4i16((LAS s16x4*)vp_)); \
            const s16x4 hi_ = __builtin_bit_cast(s16x4, __builtin_amdgcn_ds_read_tr16_b64_v4i16((LAS s16x4*)(vp_ + 512))); \
            dst[d_] = (bf16x8){lo_[0], lo_[1], lo_[2], lo_[3], hi_[0], hi_[1], hi_[2], hi_[3]}; } } while (0)
#define AT_KLD(ka_, kb_, qf_, Kb, m, s) do { const int ko_ = kfo ^ (((m) * 8 + 2 * (s)) << 4); ka_ = *(const LAS bf16x8*)((Kb) + ko_); kb_ = *(const LAS bf16x8*)((Kb) + ko_ + 8192); \
        qf_ = *(const LAS bf16x8*)(Qw + ((m) * 4 + (s)) * 1024); } while (0)
#define AT_S(m, t) do { const LAS unsigned char* Kb = lds + AT_K + ((t) & 1) * 16384; \
        bf16x8 ka_[3], kb_[3], qf_[3]; \
        AT_KLD(ka_[0], kb_[0], qf_[0], Kb, m, 0); AT_KLD(ka_[1], kb_[1], qf_[1], Kb, m, 1); \
        { const float nm_ = -mrun[m]; _Pragma("unroll") for (int i = 0; i < 16; ++i) { sA[i] = nm_; sB[i] = nm_; } } \
        _Pragma("unroll") for (int s = 0; s < 4; ++s) { \
            if (s < 2) AT_KLD(ka_[(s + 2) % 3], kb_[(s + 2) % 3], qf_[(s + 2) % 3], Kb, m, s + 2); \
            __builtin_amdgcn_sched_barrier(0); \
            sA = __builtin_amdgcn_mfma_f32_32x32x16_bf16(ka_[s % 3], qf_[s % 3], sA, 0, 0, 0); sB = __builtin_amdgcn_mfma_f32_32x32x16_bf16(kb_[s % 3], qf_[s % 3], sB, 0, 0, 0); \
            __builtin_amdgcn_sched_barrier(0); } } while (0)
#define AT_PV(m, t) do { const LAS unsigned char* Vb = lds + AT_V + ((t) & 1) * 16384; \
        bf16x8 vf_[3][4]; \
        AT_VLD(vf_[0], Vb, 0); AT_VLD(vf_[1], Vb, 1); \
        _Pragma("unroll") for (int ks = 0; ks < 4; ++ks) { \
            if (ks < 2) AT_VLD(vf_[(ks + 2) % 3], Vb, ks + 2); \
            __builtin_amdgcn_sched_barrier(0); \
            _Pragma("unroll") for (int d = 0; d < 4; ++d) O[m][d] = __builtin_amdgcn_mfma_f32_32x32x16_bf16(vf_[ks % 3][d], pf[ks], O[m][d], 0, 0, 0); \
            __builtin_amdgcn_sched_barrier(0); } } while (0)
#define AT_SM(m, t) do { \
        if ((64 * (t) + 63 - q0w) > -91) { const LAS float* bp = (const LAS float*)(lds + AT_BT) + (64 * (t) - q0w - r + AT_BT0 + 4 * hh); \
            _Pragma("unroll") for (int a = 0; a < 4; ++a) _Pragma("unroll") for (int j = 0; j < 4; ++j) { sA[4 * a + j] += bp[8 * a + j]; sB[4 * a + j] += bp[32 + 8 * a + j]; } } \
          \
        float c0_ = __builtin_fmaxf(__builtin_fmaxf(sA[0], sA[1]), sA[2]), c1_ = __builtin_fmaxf(__builtin_fmaxf(sA[8], sA[9]), sA[10]), c2_ = __builtin_fmaxf(__builtin_fmaxf(sB[0], sB[1]), sB[2]), c3_ = __builtin_fmaxf(__builtin_fmaxf(sB[8], sB[9]), sB[10]); \
        c0_ = __builtin_fmaxf(__builtin_fmaxf(c0_, sA[3]), sA[4]); c1_ = __builtin_fmaxf(__builtin_fmaxf(c1_, sA[11]), sA[12]); c2_ = __builtin_fmaxf(__builtin_fmaxf(c2_, sB[3]), sB[4]); c3_ = __builtin_fmaxf(__builtin_fmaxf(c3_, sB[11]), sB[12]); \
        c0_ = __builtin_fmaxf(__builtin_fmaxf(c0_, sA[5]), sA[6]); c1_ = __builtin_fmaxf(__builtin_fmaxf(c1_, sA[13]), sA[14]); c2_ = __builtin_fmaxf(__builtin_fmaxf(c2_, sB[5]), sB[6]); c3_ = __builtin_fmaxf(__builtin_fmaxf(c3_, sB[13]), sB[14]); \
        c0_ = __builtin_fmaxf(__builtin_fmaxf(c0_, sA[7]), c1_); c2_ = __builtin_fmaxf(__builtin_fmaxf(c2_, sB[7]), c3_); \
        float tmax = __builtin_fmaxf(__builtin_fmaxf(c0_, sA[15]), __builtin_fmaxf(c2_, sB[15])); \
        { const auto r_ = __builtin_amdgcn_permlane32_swap(__float_as_uint(tmax), __float_as_uint(tmax), false, false); tmax = __builtin_fmaxf(__uint_as_float(r_[0]), __uint_as_float(r_[1])); }     \
        if ((t) == 0 || __any(tmax > AT_THR)) {          \
            const float dl = ((t) == 0) ? tmax : fmaxf(tmax, 0.f); \
            if ((t) != 0) { const float al = __builtin_amdgcn_exp2f(-dl); lrun[m] *= al; \
                _Pragma("unroll") for (int d = 0; d < 4; ++d) _Pragma("unroll") for (int i = 0; i < 16; ++i) O[m][d][i] *= al; } \
            mrun[m] += dl; \
            _Pragma("unroll") for (int i = 0; i < 16; ++i) { sA[i] -= dl; sB[i] -= dl; } } \
        _Pragma("unroll") for (int i = 0; i < 16; ++i) { sA[i] = __builtin_amdgcn_exp2f(sA[i]); sB[i] = __builtin_amdgcn_exp2f(sB[i]); } \
        { const f32x16 s16_ = sA + sB; const f32x8v s8_ = s16_.lo + s16_.hi; const f32x4 s4_ = s8_.lo + s8_.hi; const f32x2 s2_ = s4_.lo + s4_.hi; lrun[m] += s2_.x + s2_.y; }     \
        _Pragma("unroll") for (int s2 = 0; s2 < 2; ++s2) { u32x4 pa, pb; \
            pa.x = cvt_pk_bf16(sA[8 * s2 + 0], sA[8 * s2 + 1]); pa.y = cvt_pk_bf16(sA[8 * s2 + 2], sA[8 * s2 + 3]); pa.z = cvt_pk_bf16(sA[8 * s2 + 4], sA[8 * s2 + 5]); pa.w = cvt_pk_bf16(sA[8 * s2 + 6], sA[8 * s2 + 7]); \
            pb.x = cvt_pk_bf16(sB[8 * s2 + 0], sB[8 * s2 + 1]); pb.y = cvt_pk_bf16(sB[8 * s2 + 2], sB[8 * s2 + 3]); pb.z = cvt_pk_bf16(sB[8 * s2 + 4], sB[8 * s2 + 5]); pb.w = cvt_pk_bf16(sB[8 * s2 + 6], sB[8 * s2 + 7]); \
            pf[s2] = __builtin_bit_cast(bf16x8, pa); pf[2 + s2] = __builtin_bit_cast(bf16x8, pb); } } while (0)
    const int grp = wave >> 2;
    AT_DMA_K(0, 0); AT_DMA_V(0, 0);
#define AT_SYNC(tb, ph) do { \
        if ((ph) == 0) { if ((tb) < NT) asm volatile("s_waitcnt vmcnt(2)" ::: "memory"); else asm volatile("s_waitcnt vmcnt(0)" ::: "memory"); } \
        else if ((ph) == 2) { if ((tb) + 1 < NT) asm volatile("s_waitcnt vmcnt(2)" ::: "memory"); else asm volatile("s_waitcnt vmcnt(0)" ::: "memory"); } \
        asm volatile("s_waitcnt lgkmcnt(0)" ::: "memory"); __builtin_amdgcn_s_barrier(); asm volatile("" ::: "memory"); \
        if ((ph) == 0) { if ((tb) + 1 < NT) AT_DMA_K((tb) + 1, ((tb) + 1) & 1); } \
        else if ((ph) == 2) { if ((tb) + 1 < NT) AT_DMA_V((tb) + 1, ((tb) + 1) & 1); } } while (0)
    if (grp == 0) {
#pragma unroll 1
        for (int t = 0; t < NT; ++t) {
            AT_SYNC(t, 0); if (t >= 1 && t - 1 <= cw) AT_PV(1, t - 1); if (t <= cw) AT_S(0, t);
            AT_SYNC(t, 1); if (t <= cw) AT_SM(0, t);
            AT_SYNC(t, 2); if (t <= cw) { AT_PV(0, t); AT_S(1, t); }
            AT_SYNC(t, 3); if (t <= cw) AT_SM(1, t);
        }
        AT_SYNC(NT, 0); if (NT - 1 <= cw) AT_PV(1, NT - 1);
        AT_SYNC(NT, 1);
    } else {
#pragma unroll 1
        for (int t = 0; t < NT; ++t) {
            AT_SYNC(t, 0); if (t >= 1 && t - 1 <= cw) AT_SM(1, t - 1);
            AT_SYNC(t, 1); if (t >= 1 && t - 1 <= cw) AT_PV(1, t - 1); if (t <= cw) AT_S(0, t);
            AT_SYNC(t, 2); if (t <= cw) AT_SM(0, t);
            AT_SYNC(t, 3); if (t <= cw) { AT_PV(0, t); AT_S(1, t); }
        }
        AT_SYNC(NT, 0); if (NT - 1 <= cw) AT_SM(1, NT - 1);
        AT_SYNC(NT, 1); if (NT - 1 <= cw) AT_PV(1, NT - 1);
    }
#undef AT_SYNC
#undef AT_S
#undef AT_VLD
#undef AT_KLD
#undef AT_PV
#undef AT_SM
#undef AT_DMA_K
#undef AT_DMA_V
    const float l0 = lrun[0] + __shfl_xor(lrun[0], 32), l1 = lrun[1] + __shfl_xor(lrun[1], 32);
    const float lam_v = *(const LAS float*)(lds + AT_LAM);
    const float i0 = 1.f / l0, i1 = lam_v / l1;
    float ss = 0.f;
#pragma unroll
    for (int d = 0; d < 4; ++d)
#pragma unroll
        for (int i = 0; i < 16; ++i) { const float o = O[0][d][i] * i0 - O[1][d][i] * i1; O[0][d][i] = o; ss += o * o; }
    ss += __shfl_xor(ss, 32);
    const float rs = (1.f - LAMBDA_INIT) / sqrtf(ss * (1.f / 128.f) + LN_EPS);
    unsigned char* op = (unsigned char*)mixin + (size_t)(rowbase + q0w + r) * DM + 512 + h * 128;
#pragma unroll
    for (int d = 0; d < 4; ++d)
#pragma unroll
        for (int a = 0; a < 4; ++a) { const int dd = 32 * d + 8 * a + 4 * hh; const f32x4 g = *(const f32x4*)(subln_g + dd);
            *(unsigned*)(op + dd) = pk4_fp8(O[0][d][4 * a] * rs * g[0], O[0][d][4 * a + 1] * rs * g[1], O[0][d][4 * a + 2] * rs * g[2], O[0][d][4 * a + 3] * rs * g[3]); }
    __syncthreads();
}

__device__ __forceinline__ void p5_ln1(const float* x, const bf16_t* mix, const float* modf, const float* ln_g, const float* ln_b, bf16_t* x1s, bf16_t* h2, unsigned char* h2f8, int pm, int wave, int lane) {
    const int row0 = pm * 256 + wave * 32, b = row0 >> 11;
    const float* mb = modf + (size_t)b * 6144;
    float g1[16], lg[16], lb[16], s2[16], t2[16];
#pragma unroll
    for (int w = 0; w < 4; ++w) { const int col = 256 * w + 4 * lane;
        const f32x4 a = *(const f32x4*)(mb + 2048 + col), bq = *(const f32x4*)(ln_g + col), c = *(const f32x4*)(ln_b + col), d = *(const f32x4*)(mb + 3072 + col), e = *(const f32x4*)(mb + 4096 + col);
#pragma unroll
        for (int q = 0; q < 4; ++q) { g1[w * 4 + q] = a[q]; lg[w * 4 + q] = bq[q]; lb[w * 4 + q] = c[q]; t2[w * 4 + q] = d[q]; s2[w * 4 + q] = 1.f + e[q]; } }
#pragma unroll 1
    for (int r2 = 0; r2 < 32; r2 += 2) {
        f32x4 xa[2][4]; u32x2 mm[2][4];
#pragma unroll
        for (int q = 0; q < 2; ++q) { const size_t ro = (size_t)(row0 + r2 + q) * DM + 4 * lane;
#pragma unroll
            for (int w = 0; w < 4; ++w) { xa[q][w] = *(const f32x4*)(x + ro + 256 * w); mm[q][w] = *(const u32x2*)(mix + ro + 256 * w); } }
#pragma unroll
        for (int q = 0; q < 2; ++q) {
            const size_t ro = (size_t)(row0 + r2 + q) * DM + 4 * lane;
            float v[16];
#pragma unroll
            for (int w = 0; w < 4; ++w) { const f32x4 a = xa[q][w]; const u32x2 m = mm[q][w];
                v[w * 4 + 0] = ALPHA * a[0] + g1[w * 4 + 0] * bf_lo(m.x); v[w * 4 + 1] = ALPHA * a[1] + g1[w * 4 + 1] * bf_hi(m.x);
                v[w * 4 + 2] = ALPHA * a[2] + g1[w * 4 + 2] * bf_lo(m.y); v[w * 4 + 3] = ALPHA * a[3] + g1[w * 4 + 3] * bf_hi(m.y); }
            float s = 0.f;
#pragma unroll
            for (int k = 0; k < 16; ++k) s += v[k];
            const float mean = wave_sum(s) * (1.f / DM);
            float q2 = 0.f;
#pragma unroll
            for (int k = 0; k < 16; ++k) { v[k] -= mean; q2 += v[k] * v[k]; }
            const float rstd = 1.f / sqrtf(wave_sum(q2) * (1.f / DM) + LN_EPS);
            float x1[16], hv[16];
#pragma unroll
            for (int k = 0; k < 16; ++k) { x1[k] = v[k] * rstd * lg[k] + lb[k]; hv[k] = x1[k] * s2[k] + t2[k]; }
#pragma unroll
            for (int w = 0; w < 4; ++w) { u32x2 w1, w2;
                w1.x = cvt_pk_bf16(ALPHA * x1[w * 4 + 0], ALPHA * x1[w * 4 + 1]); w1.y = cvt_pk_bf16(ALPHA * x1[w * 4 + 2], ALPHA * x1[w * 4 + 3]);
                w2.x = cvt_pk_bf16(hv[w * 4 + 0], hv[w * 4 + 1]); w2.y = cvt_pk_bf16(hv[w * 4 + 2], hv[w * 4 + 3]);
                *(u32x2*)(x1s + ro + 256 * w) = w1; *(u32x2*)(h2 + ro + 256 * w) = w2;
                *(unsigned*)(h2f8 + ro + 256 * w) = pk4_fp8(hv[w * 4 + 0], hv[w * 4 + 1], hv[w * 4 + 2], hv[w * 4 + 3]); }
        }
    }
}
typedef unsigned long long u64_t;
__device__ __forceinline__ float sigm_fast(float x) { return __builtin_amdgcn_rcpf(1.f + __builtin_amdgcn_exp2f(-LOG2E * x)); }
__device__ __forceinline__ u64_t rkey(float s, int e) { const unsigned u = __builtin_bit_cast(unsigned, s); const unsigned o = u ^ ((u >> 31) ? 0xFFFFFFFFu : 0x80000000u); return ((u64_t)o << 32) | (unsigned)(~e); }
__device__ __forceinline__ float rkey_score(u64_t k) { const unsigned o = (unsigned)(k >> 32); const unsigned u = (o & 0x80000000u) ? (o ^ 0x80000000u) : ~o; return __builtin_bit_cast(float, u); }
#define TOP8_INSERT(key) do { const u64_t k__ = (key); if (k__ > tk[7]) { tk[7] = k__; \
        _Pragma("unroll") for (int p_ = 7; p_ > 0; --p_) { const u64_t hi_ = tk[p_] > tk[p_ - 1] ? tk[p_] : tk[p_ - 1], lo_ = tk[p_] > tk[p_ - 1] ? tk[p_ - 1] : tk[p_]; tk[p_ - 1] = hi_; tk[p_] = lo_; } } } while (0)
__device__ __forceinline__ void p5_route_quad(const float* logits, LAS float* L, const LAS float* rb, LAS unsigned* hist, int* ae, float* aw, int* ar, int tid, int tok) {
    const int q = tid & 3;
    LAS float* mine = L + tid * 65;
    const LAS float* rbq = rb + 64 * q;
    float gsum[2], gm2[2];
    { const f32x4* src = (const f32x4*)(logits + (size_t)tok * NEXP + 64 * q);
      f32x4 v[16];
#pragma unroll
      for (int i = 0; i < 16; ++i) v[i] = src[i];
#pragma unroll
      for (int gg = 0; gg < 2; ++gg) { float m1 = -1e30f, m2 = -1e30f;
#pragma unroll
          for (int j = 0; j < 32; ++j) { const int jj = gg * 32 + j; const float s = sigm_fast(v[jj >> 2][jj & 3]) + rbq[jj]; mine[jj] = s;
              if (s > m1) { m2 = m1; m1 = s; } else if (s > m2) m2 = s; }
          gsum[gg] = m1 + m2; gm2[gg] = m2; } }
    float gs[8];
    { const float a0 = __shfl_xor(gsum[0], 1), a1 = __shfl_xor(gsum[1], 1);
      float p0 = (q & 1) ? a0 : gsum[0], p1 = (q & 1) ? a1 : gsum[1], p2 = (q & 1) ? gsum[0] : a0, p3 = (q & 1) ? gsum[1] : a1;
      const float b0 = __shfl_xor(p0, 2), b1 = __shfl_xor(p1, 2), b2 = __shfl_xor(p2, 2), b3 = __shfl_xor(p3, 2);
      const bool hi = (q & 2) != 0;
      gs[0] = hi ? b0 : p0; gs[1] = hi ? b1 : p1; gs[2] = hi ? b2 : p2; gs[3] = hi ? b3 : p3;
      gs[4] = hi ? p0 : b0; gs[5] = hi ? p1 : b1; gs[6] = hi ? p2 : b2; gs[7] = hi ? p3 : b3; }
    unsigned selmask = 0u;
#pragma unroll
    for (int g = 0; g < 8; ++g) { int rank = 0;
#pragma unroll
        for (int o = 0; o < 8; ++o) rank += (gs[o] > gs[g] || (gs[o] == gs[g] && o < g)) ? 1 : 0;
        if (rank < 4) selmask |= 1u << g; }
    const bool sel0 = (selmask >> (2 * q)) & 1u, sel1 = (selmask >> (2 * q + 1)) & 1u;
    float tau = fminf(sel0 ? gm2[0] : 3e38f, sel1 ? gm2[1] : 3e38f);
    tau = fminf(tau, __shfl_xor(tau, 1)); tau = fminf(tau, __shfl_xor(tau, 2));
    u64_t cand = 0ull;
#pragma unroll 8
    for (int j = 0; j < 64; ++j) { const bool ok = (mine[j] >= tau) && ((j < 32) ? sel0 : sel1); cand |= ok ? (1ull << j) : 0ull; }
    u64_t tk[8];
#pragma unroll
    for (int k = 0; k < 8; ++k) tk[k] = 0ull;
    while (__any(cand != 0ull)) {
        if (cand != 0ull) { const int j = __builtin_ctzll(cand); cand &= cand - 1ull; TOP8_INSERT(rkey(mine[j], 64 * q + j)); }
    }
#pragma unroll
    for (int rnd = 1; rnd <= 2; ++rnd) {
        u64_t ok[8];
#pragma unroll
        for (int k = 0; k < 8; ++k) { const unsigned lo = __shfl_xor((unsigned)tk[k], rnd), hi = __shfl_xor((unsigned)(tk[k] >> 32), rnd); ok[k] = ((u64_t)hi << 32) | lo; }
#pragma unroll
        for (int k = 0; k < 8; ++k) TOP8_INSERT(ok[k]);
    }
    float wv[8]; int ei[8]; float wsum = 0.f;
#pragma unroll
    for (int k = 0; k < 8; ++k) { ei[k] = (int)(~(unsigned)tk[k]) & 255; wv[k] = rkey_score(tk[k]) - rb[ei[k]]; wsum += wv[k]; }
    const float inv = 2.5f / wsum;
#pragma unroll
    for (int k = 0; k < 8; ++k) if ((k >> 1) == q) { const unsigned rk = __hip_atomic_fetch_add(hist + ei[k], 1u, __ATOMIC_RELAXED, __HIP_MEMORY_SCOPE_WORKGROUP);
        ae[(size_t)tok * 8 + k] = ei[k]; aw[(size_t)tok * 8 + k] = wv[k] * inv; ar[(size_t)tok * 8 + k] = (int)rk; }
}
__device__ __forceinline__ void p6_phase(unsigned char* ws, LAS unsigned char* misc, int wg, int G, int tid) {
    const int* cnt = (const int*)(ws + WS_CNT); const int* ae = (const int*)(ws + WS_AE); const float* aw = (const float*)(ws + WS_AW); int* ar = (int*)(ws + WS_AR);
    int* stok = (int*)(ws + WS_STOK); int* sdst = (int*)(ws + WS_SDST); float* sw = (float*)(ws + WS_SW); int* tile_e = (int*)(ws + WS_TILE_E);
    LAS int* tot = (LAS int*)misc; LAS int* part = (LAS int*)(misc + 1024); LAS int* start = (LAS int*)(misc + 2048);
    const int npan = NTOK / 256;
    {
        const int e = tid & (NEXP - 1), hf = tid >> 8, w0 = hf * (npan / 2);
        int t = 0, p = 0;
#pragma unroll 16
        for (int w = w0; w < w0 + npan / 2; ++w) { const int c = cnt[w * NEXP + e]; t += c; p += (w < wg) ? c : 0; }
        LAS int* tmp = (LAS int*)(misc + 8192);
        if (hf) { tmp[e] = t; tmp[NEXP + e] = p; }
        __syncthreads();
        if (!hf) { tot[e] = t + tmp[e]; part[e] = p + tmp[NEXP + e]; }
    }
    __syncthreads();
    if (tid < 64) {
        int pd[4], s = 0;
#pragma unroll
        for (int j = 0; j < 4; ++j) { pd[j] = (tot[4 * tid + j] + 255) & ~255; s += pd[j]; }
        int incl = s;
#pragma unroll
        for (int o = 1; o < 64; o <<= 1) { const int v = __shfl_up(incl, o); if (tid >= o) incl += v; }
        int acc = incl - s;
#pragma unroll
        for (int j = 0; j < 4; ++j) { start[4 * tid + j] = acc; acc += pd[j]; }
        if (tid == 63 && wg == 0) tile_e[4096] = incl >> 8;
    }
    __syncthreads();
    for (int pan = wg; pan < npan; pan += G) {
        if (pan != wg) { __syncthreads(); if (tid < NEXP) { int p = 0; for (int w = 0; w < pan; ++w) p += cnt[w * NEXP + tid]; part[tid] = p; } __syncthreads(); }
        for (int i = tid; i < 256 * 8; i += 512) { const size_t a = (size_t)pan * 2048 + i; const int e = ae[a]; const int slot = start[e] + part[e] + ar[a];
            stok[slot] = (int)(a >> 3); sdst[slot] = (int)a; sw[slot] = aw[a]; ar[a] = slot; }
    }
    for (int e = wg; e < NEXP; e += G) { const int t = tot[e], pad = ((t + 255) & ~255) - t, s0 = start[e] + t;
        for (int i = tid; i < pad; i += 512) { stok[s0 + i] = 0; sdst[s0 + i] = -1; sw[s0 + i] = 0.f; }
        const int nt = (t + 255) >> 8, t0 = start[e] >> 8;
        for (int i = tid; i < nt; i += 512) tile_e[t0 + i] = e; }
}
__device__ __forceinline__ void p9_phase(const unsigned char* Y, const int* slotof, const bf16_t* x1s, const float* modf, const float* ln_g, const float* ln_b, float* out, int gw, int NGW, int lane) {
    for (int blk = gw; blk < NTOK / 32; blk += NGW) {
        const int row0 = blk * 32, b = row0 >> 11;
        float g2[16], lg[16], lb[16];
#pragma unroll
        for (int k = 0; k < 16; ++k) { g2[k] = modf[(size_t)b * 6144 + 5120 + 16 * lane + k] * YINV; lg[k] = ln_g[16 * lane + k]; lb[k] = ln_b[16 * lane + k]; }
#pragma unroll 4
        for (int rr = 0; rr < 32; ++rr) {
            const int row = row0 + rr;
            float f[16];
#pragma unroll
            for (int k = 0; k < 16; ++k) f[k] = 0.f;
            int sl[8];
#pragma unroll
            for (int s = 0; s < 8; ++s) sl[s] = __builtin_amdgcn_readfirstlane(slotof[(size_t)row * 8 + s]);
#pragma unroll
            for (int s = 0; s < 8; ++s) { const u32x4 pk = *(const u32x4*)(Y + (size_t)sl[s] * 1024 + 16 * lane);
#pragma unroll
                for (int w = 0; w < 4; ++w) { const f32x2 lo = __builtin_amdgcn_cvt_pk_f32_fp8((int)pk[w], false), hi = __builtin_amdgcn_cvt_pk_f32_fp8((int)pk[w], true);
                    f[4 * w + 0] += lo[0]; f[4 * w + 1] += lo[1]; f[4 * w + 2] += hi[0]; f[4 * w + 3] += hi[1]; } }
            const u32x4 xa = *(const u32x4*)(x1s + (size_t)row * DM + 16 * lane), xb = *(const u32x4*)(x1s + (size_t)row * DM + 16 * lane + 8);
            float v[16];
#pragma unroll
            for (int w = 0; w < 4; ++w) { v[2 * w] = bf_lo(xa[w]) + g2[2 * w] * f[2 * w]; v[2 * w + 1] = bf_hi(xa[w]) + g2[2 * w + 1] * f[2 * w + 1];
                v[8 + 2 * w] = bf_lo(xb[w]) + g2[8 + 2 * w] * f[8 + 2 * w]; v[8 + 2 * w + 1] = bf_hi(xb[w]) + g2[8 + 2 * w + 1] * f[8 + 2 * w + 1]; }
            float s = 0.f;
#pragma unroll
            for (int k = 0; k < 16; ++k) s += v[k];
            const float mean = wave_sum(s) * (1.f / DM);
            float q2 = 0.f;
#pragma unroll
            for (int k = 0; k < 16; ++k) { v[k] -= mean; q2 += v[k] * v[k]; }
            const float rstd = 1.f / sqrtf(wave_sum(q2) * (1.f / DM) + LN_EPS);
            float* orow = out + (size_t)row * DM + 16 * lane;
#pragma unroll
            for (int w = 0; w < 4; ++w) *(f32x4*)(orow + 4 * w) = (f32x4){v[4 * w] * rstd * lg[4 * w] + lb[4 * w], v[4 * w + 1] * rstd * lg[4 * w + 1] + lb[4 * w + 1], v[4 * w + 2] * rstd * lg[4 * w + 2] + lb[4 * w + 2], v[4 * w + 3] * rstd * lg[4 * w + 3] + lb[4 * w + 3]};
        }
    }
}

#ifndef MK_N_LAUNCHES
#define MK_N_LAUNCHES 1
#endif
constexpr int N_PHASES = 10;
constexpr int CV_SPLIT = (P0_N_EXP / 3) / 2048 * 2048;
struct Args { const float* in[26]; float* out; unsigned char* ws; int ph_lo, ph_hi; };
__global__ void __launch_bounds__(NWAVES * 64, 2) mega_fwd(Args args) {
    extern __shared__ __attribute__((aligned(16))) unsigned char lds_raw[];
    LAS unsigned char* lds = (LAS unsigned char*)lds_raw;
    LAS unsigned char* misc = lds + MISC_OFF;
    const int tid_arg = threadIdx.x, wave = __builtin_amdgcn_readfirstlane(tid_arg >> 6);
    const int G = gridDim.x, bx = blockIdx.x, vcu = (G % 8 == 0) ? (bx % 8) * (G / 8) + bx / 8 : bx;
    const int gw = vcu * NWAVES + wave, NGW = G * NWAVES;
    unsigned char* ws_arg = args.ws;
    const int lo = args.ph_lo, hi = args.ph_hi;
    volatile LAS unsigned* xbw = (volatile LAS unsigned*)(misc + 4032);
    if (tid_arg < 4) xbw[tid_arg] = 0u;
    __syncthreads();
    XcdBarrier bar; bar.bar = (unsigned*)(ws_arg + WS_CTL) + CW_BAR; bar.x = 0; bar.st = xbw;
    if (hi - lo > 1) bar = xcd_barrier_post((unsigned*)(ws_arg + WS_CTL) + CW_BAR, xbw);
#define IN(k) (lo <= (k) && (k) < hi)
#define SEAM(k) do { if (IN(k) && IN((k) + 1)) xcd_barrier(bar); } while (0)
#define CAS __attribute__((address_space(4)))
#define GP(T, p) ((T*)(GAS T*)(p))
#define KARGS() const CAS Args* ka = (const CAS Args*)__builtin_amdgcn_kernarg_segment_ptr(); asm volatile("" : "+s"(ka)); unsigned char* ws = GP(unsigned char, ka->ws); float* outp = GP(float, ka->out); (void)outp
#define AIN(k) GP(const float, ka->in[k])
#define LAUNDER() KARGS(); int tid = tid_arg; asm volatile("" : "+v"(tid)); const int lane = tid & 63

    if (IN(0)) { LAUNDER();
        P0Ptrs P; P.c = AIN(1); P.w_ada = AIN(2); P.w_in = AIN(4); P.w_out = AIN(12); P.w_router = AIN(15); P.ws_gate = AIN(20); P.ws_up = AIN(21); P.ws_down = AIN(22);
        P.pool_w = AIN(5); P.w_gate = AIN(17); P.w_up = AIN(18); P.w_down = AIN(19); P.ws = ws;
        p0_phase(P, lds, gw, NGW, wave, lane);
    }
    SEAM(0);
    if (IN(1)) { LAUNDER(); p1_phase(AIN(0), AIN(3), ws, gw, NGW, lane, bx * (NWAVES * 64) + tid, G * NWAVES * 64); }
    SEAM(1);
    if (IN(2)) { LAUNDER();
        const int grp4 = vcu & 3, k0 = (grp4 == 0) ? 0 : (grp4 == 1) ? 3 : (grp4 == 2) ? 5 : 8;
        const int nrounds = (NTOK / 256) * (IND / 256) / G;
        DenseOrder S; S.init(ws + WS_BUFA, ws + WS_WIN, NTOK, IND, DM / 2, G, bx); S.gmode = 1;
        EpiDenseBf16 E{(bf16_t*)outp, IND, 2, 4, QSCALE, 1.f / WSCALE};
        if (k0 > 0) { S.ioff = 0; S.imax = k0; pg8::gemm_phase<EpiDenseBf16, DenseOrder, true, true, true>(lds, DM / 2, S, E); __syncthreads(); }
        p0_expert_stream(AIN(17), AIN(18), AIN(19), ws, lds, gw, NGW, wave, lane, 0, CV_SPLIT); VM_WAIT(); __syncthreads();
        if (k0 < nrounds + 1) { S.ioff = k0; S.imax = 1 << 30; pg8::gemm_phase<EpiDenseBf16, DenseOrder, true, true, true>(lds, DM / 2, S, E); }
    }
    SEAM(2);
    if (IN(3)) { LAUNDER();
        const bf16_t* proj = (const bf16_t*)outp; bf16_t* mixin = (bf16_t*)(ws + WS_BUFA);
        int gl = -1;
        for (int u = vcu; u < 2048; u += G) { const int g = u & 3, ht = u >> 2;
            if (g != gl) { __syncthreads(); pool_load_w((const bf16_t*)(ws + WS_WPOOL), g, lds, tid); gl = g; }
            pool_unit(proj, mixin, AIN(6), ht, g, lds, tid, wave, lane); }
        __syncthreads();
        const float s1 = wave_sum(AIN(7)[lane] * AIN(8)[lane]), s2 = wave_sum(AIN(9)[lane] * AIN(10)[lane]);
        { const float lam0 = __expf(s1) - __expf(s2) + LAMBDA_INIT; if (tid == 0) *(LAS float*)(lds + AT_LAM) = lam0; }
        const float lam = 0.f;
        const int nun = (G == 256) ? 4 : (1024 - vcu + G - 1) / G;
#pragma unroll 1
        for (int i = 0; i <= nun; ++i) {
            if (i == ((vcu & 3) * nun) / 3) {
                int ln_ = lane; asm volatile("" : "+v"(ln_));
                p0_expert_stream(AIN(17), AIN(18), AIN(19), ws, lds, gw, NGW, wave, ln_, CV_SPLIT, P0_N_EXP); VM_WAIT(); __syncthreads(); }
            if (i == nun) break;
            int bh, qb;
            if (G == 256) { const int p = vcu & 1; bh = vcu >> 1; qb = p ? ((i == 0) ? 6 : (i == 1) ? 1 : (i == 2) ? 5 : 2) : ((i == 0) ? 7 : (i == 1) ? 0 : (i == 2) ? 4 : 3); }
            else { const int u = vcu + i * G; bh = u >> 3; qb = u & 7; }
            attn_unit(proj, mixin, AIN(25), AIN(11), lam, bh >> 2, bh & 3, qb, lds, tid, wave, lane);
        }
    }
    SEAM(3);
    if (IN(4)) { LAUNDER(); (void)lane;
        DenseOrder S; S.init(ws + WS_BUFA, ws + WS_WOUT, NTOK, DM, DM / 2, G, bx); S.gmode = 1;
        EpiDenseBf16 E{(bf16_t*)(ws + WS_BUFB), DM, 0, 0, 1.f, 1.f / WSCALE};
        pg8::gemm_phase<EpiDenseBf16, DenseOrder, true, true, true>(lds, DM / 2, S, E);
    }
    SEAM(4);
    if (IN(5)) {
        KARGS();
#pragma unroll 1
        for (int pm = vcu; pm < NTOK / 256; pm += G) {
            int tid = tid_arg; asm volatile("" : "+v"(tid)); const int lane = tid & 63;
            p5_ln1(AIN(0), (const bf16_t*)(ws + WS_BUFB), (const float*)(ws + WS_MODF), AIN(13), AIN(14), (bf16_t*)(ws + WS_X1), (bf16_t*)(ws + WS_BUFA), ws + WS_H2F8, pm, wave, lane);
            VM_WAIT(); __syncthreads(); __builtin_amdgcn_fence(__ATOMIC_ACQUIRE, "agent"); VM_WAIT();
            OneUnit S{(const char*)(ws + WS_BUFA), (const char*)(ws + WS_WR), pm};
            float* logits = outp;
            EpiLogits E{logits};
            pg8::gemm_phase<EpiLogits, OneUnit, false, false>(lds, DM, S, E);
            asm volatile("" : "+v"(tid));
            LAS float* rb = (LAS float*)(misc + 4096); LAS unsigned* hist = (LAS unsigned*)(misc + 5120);
            if (tid < NEXP) { rb[tid] = AIN(16)[tid]; hist[tid] = 0u; }
            VM_WAIT(); __syncthreads(); __builtin_amdgcn_fence(__ATOMIC_ACQUIRE, "agent"); VM_WAIT();
#pragma unroll 1
            for (int half = 0; half < 2; ++half)
                p5_route_quad(logits, (LAS float*)lds, rb, hist, (int*)(ws + WS_AE), (float*)(ws + WS_AW), (int*)(ws + WS_AR), tid, pm * 256 + (half & 1) * 128 + (tid >> 2));
            __syncthreads();
            if (tid < NEXP) ((int*)(ws + WS_CNT))[pm * NEXP + tid] = (int)hist[tid];
            __syncthreads();
        }
    }
    SEAM(5);
    if (IN(6)) { LAUNDER(); (void)lane; p6_phase(ws, misc, bx, G, tid); }
    SEAM(6);
    if (IN(7)) { LAUNDER(); (void)lane;
        const int* tile_e = (const int*)(ws + WS_TILE_E);
        const int T = ((cint_p)tile_e)[4096];
        GateUpOrder S{(const char*)(ws + WS_H2F8), (const char*)(ws + WS_WGU), (const char*)(ws + WS_WSGU), (const int*)(ws + WS_STOK), tile_e, T, G, vcu};
        EpiGateUp E{(char*)outp, nullptr};
        pg8::gemm_phase<EpiGateUp, GateUpOrder, true, true, true>(lds, DM / 2, S, E);
    }
    SEAM(7);
    if (IN(8)) { LAUNDER(); (void)lane;
        const int* tile_e = (const int*)(ws + WS_TILE_E);
        const int T = ((cint_p)tile_e)[4096];
        DownOrder S{(char*)outp, nullptr, (const char*)(ws + WS_WD), (const char*)(ws + WS_WSD), tile_e, (const int*)(ws + WS_SDST), (const float*)(ws + WS_SW), T, G, vcu, 0};
        S.plan();
        EpiDown<false> E{ws + WS_Y, (bf16_t*)(ws + WS_X1), (const float*)(ws + WS_MODF), lds};
        pg8::gemm_phase<EpiDown<false>, DownOrder, true, true, true, true>(lds, EDIM / 2, S, E);
        DownOrder S2 = S; S2.shared = 1; S2.plan();
        EpiDown<true> E2{ws + WS_Y, (bf16_t*)(ws + WS_X1), (const float*)(ws + WS_MODF), lds};
        pg8::gemm_phase<EpiDown<true>, DownOrder, true, true, true, true>(lds, EDIM / 2, S2, E2);
    }
    SEAM(8);
    if (IN(9)) { LAUNDER(); p9_phase(ws + WS_Y, (const int*)(ws + WS_AR), (const bf16_t*)(ws + WS_X1), (const float*)(ws + WS_MODF), AIN(23), AIN(24), outp, gw, NGW, lane); }
#undef IN
#undef SEAM
}

extern "C" void kernel_launch(void* const* d_in, const int* in_sizes, int n_in, void* d_out, int out_size, void* d_ws, size_t ws_size, hipStream_t stream) {
    static int grid = 0;
    if (grid == 0) {
        if (n_in != 26 || in_sizes[0] != NTOK * DM || out_size != NTOK * DM || ws_size < WS_END) {
            fprintf(stderr, "kernel_launch: unexpected problem: n_in %d, in0 %d, out %d, ws %zu (need %zu); nothing launched\n", n_in, n_in > 0 ? in_sizes[0] : -1, out_size, ws_size, (size_t)WS_END); grid = -1; return; }
        int dev = 0, cus = 0, per_cu = 0;
        if (hipGetDevice(&dev) != hipSuccess || hipDeviceGetAttribute(&cus, hipDeviceAttributeMultiprocessorCount, dev) != hipSuccess) { fprintf(stderr, "kernel_launch: device query failed\n"); grid = -1; return; }
        if (hipFuncSetAttribute((const void*)mega_fwd, hipFuncAttributeMaxDynamicSharedMemorySize, LDS_BYTES) != hipSuccess) { fprintf(stderr, "kernel_launch: hipFuncSetAttribute failed\n"); grid = -1; return; }
        if (hipOccupancyMaxActiveBlocksPerMultiprocessor(&per_cu, (const void*)mega_fwd, NWAVES * 64, LDS_BYTES) != hipSuccess || per_cu < 1)
            fprintf(stderr, "kernel_launch: note: occupancy query reports %d workgroups per CU\n", per_cu);
        (void)hipGetLastError();
        grid = cus;
    }
    if (grid < 0) return;
    if (hipMemsetAsync((char*)d_ws + WS_CTL, 0, CTL_ZERO_BYTES, stream) != hipSuccess) { fprintf(stderr, "kernel_launch: memset failed\n"); return; }
    Args a{};
    for (int i = 0; i < 26; ++i) a.in[i] = (const float*)d_in[i];
    a.out = (float*)d_out; a.ws = (unsigned char*)d_ws;
    if (MK_N_LAUNCHES == 1) {
        a.ph_lo = 0; a.ph_hi = N_PHASES;
        hipLaunchKernelGGL(mega_fwd, dim3(grid), dim3(NWAVES * 64), LDS_BYTES, stream, a);
    } else {
        for (int p = 0; p < N_PHASES; ++p) { a.ph_lo = p; a.ph_hi = p + 1; hipLaunchKernelGGL(mega_fwd, dim3(grid), dim3(NWAVES * 64), LDS_BYTES, stream, a); }
    }
    const hipError_t le = hipPeekAtLastError();
    if (le != hipSuccess) fprintf(stderr, "kernel_launch: launch failed: %s\n", hipGetErrorName(le));
}
```

```cpp
#define MK_N_LAUNCHES 1
#include <hip/hip_runtime.h>
#include <cstdio>
#include <cstdint>

#define LAS __attribute__((address_space(3)))
#define GAS __attribute__((address_space(1)))
typedef unsigned short bf16_t;
typedef short bf16x8 __attribute__((ext_vector_type(8)));
typedef short s16x4 __attribute__((ext_vector_type(4)));
typedef float f32x2 __attribute__((ext_vector_type(2)));
typedef float f32x4 __attribute__((ext_vector_type(4)));
typedef float f32x16 __attribute__((ext_vector_type(16)));
typedef unsigned u32x2 __attribute__((ext_vector_type(2)));
typedef unsigned u32x4 __attribute__((ext_vector_type(4)));
typedef GAS unsigned gu32;
#define RLX_AGENT __ATOMIC_RELAXED, __HIP_MEMORY_SCOPE_AGENT
#define LDS_WAIT() asm volatile("s_waitcnt lgkmcnt(0)" ::: "memory")
#define VM_WAIT() asm volatile("s_waitcnt vmcnt(0)" ::: "memory")

constexpr int DM = 1024, NB = 32, SEQ = 2048, NTOK = NB * SEQ, IND = 2048, NEXP = 256, TOPK = 8, EDIM = 256;
constexpr float LN_EPS = 1e-5f;
constexpr float ALPHA = 1.189207115002721f;
constexpr float LOG2E = 1.4426950408889634f;
constexpr float QSCALE = 0.125f * LOG2E;
constexpr float LAMBDA_INIT = 0.2f;
constexpr float YSCALE = 64.f, YINV = 1.f / 64.f;
constexpr float WSCALE = 64.f, HSCALE = 4.f;
constexpr int NWAVES = 8;

constexpr size_t MiB = 1u << 20;
constexpr size_t WS_CTL = 0, CTL_ZERO_BYTES = 64 * 1024;
constexpr size_t WS_MODP = 1 * MiB;
constexpr size_t WS_MODF = 4 * MiB;
constexpr size_t WS_WIN = 5 * MiB;
constexpr size_t WS_WOUT = 9 * MiB;
constexpr size_t WS_WR = 11 * MiB;
constexpr size_t WS_WSGU = 11 * MiB + 512 * 1024;
constexpr size_t WS_WSD = 12 * MiB + 512 * 1024;
constexpr size_t WS_WPOOL = 13 * MiB;
constexpr size_t WS_AE = 14 * MiB;
constexpr size_t WS_AW = 16 * MiB;
constexpr size_t WS_AR = 18 * MiB;
constexpr size_t WS_CNT = 20 * MiB;
constexpr size_t WS_TILE_E = 20 * MiB + 512 * 1024;
constexpr size_t WS_STOK = 21 * MiB;
constexpr size_t WS_SDST = 24 * MiB;
constexpr size_t WS_SW = 27 * MiB;
constexpr size_t WS_WD = 30 * MiB;
constexpr size_t WS_X1 = 158 * MiB;
constexpr size_t WS_WGU = 286 * MiB;
constexpr size_t WS_H2F8 = 414 * MiB;
constexpr size_t WS_BUFA = 542 * MiB;
constexpr size_t WS_BUFB = 670 * MiB;
constexpr size_t WS_Y = 286 * MiB;
constexpr size_t WS_END = 862 * MiB;
static_assert(WS_Y + (size_t)589824 * 1024 <= WS_END && WS_BUFB + (size_t)NTOK * DM * 2 <= WS_END && WS_H2F8 + (size_t)NTOK * DM <= WS_BUFA, "ws map");
constexpr int CW_BAR = 1024;
constexpr int H_SHARED0 = 2304;

constexpr int RING_BYTES = 131072;
constexpr int MISC_OFF = RING_BYTES;
constexpr int LDS_BYTES = 147456;

__device__ __forceinline__ unsigned cvt_pk_bf16(float lo, float hi) { unsigned r; asm volatile("v_cvt_pk_bf16_f32 %0, %1, %2" : "=v"(r) : "v"(lo), "v"(hi)); return r; }
__device__ __forceinline__ float clamp8(float v) { return __builtin_fminf(__builtin_fmaxf(v, -448.f), 448.f); }
__device__ __forceinline__ unsigned pk4_fp8(float a, float b, float c, float d) { int p = __builtin_amdgcn_cvt_pk_fp8_f32(clamp8(a), clamp8(b), 0, false); p = __builtin_amdgcn_cvt_pk_fp8_f32(clamp8(c), clamp8(d), p, true); return (unsigned)p; }
__device__ __forceinline__ float bf_lo(unsigned u) { return __builtin_bit_cast(float, u << 16); }
__device__ __forceinline__ float bf_hi(unsigned u) { return __builtin_bit_cast(float, u & 0xffff0000u); }
__device__ __forceinline__ float wave_sum(float v) {
#pragma unroll
    for (int o = 1; o < 64; o <<= 1) v += __shfl_xor(v, o);
    return v;
}
__device__ __forceinline__ float sigmoidf_(float x) { return __builtin_amdgcn_rcpf(1.f + __expf(-x)); }
__device__ __forceinline__ float sigmoid_exact(float x) { return 1.f / (1.f + __expf(-x)); }
__device__ __forceinline__ int crow(int r, int hi) { return (r & 3) + 8 * (r >> 2) + 4 * hi; }

#define XB_TMO      128
#define XB_XCNT(j)  (256  + 64 * (j))
#define XB_XSUB(j)  (1280 + 64 * (j))
#define XB_XGEN(j)  (2304 + 64 * (j))
#define XB_TOP      3328
#define XB_TOPGEN   3392
#define XCD_BAR_WORDS 3456
#define XB_SPIN_CAP (1u << 18)

__device__ __forceinline__ unsigned xb_ld(unsigned* p)              { return __hip_atomic_load(p, __ATOMIC_RELAXED, __HIP_MEMORY_SCOPE_AGENT); }
__device__ __forceinline__ unsigned xb_add(unsigned* p, unsigned v) { return __hip_atomic_fetch_add(p, v, __ATOMIC_RELAXED, __HIP_MEMORY_SCOPE_AGENT); }
__device__ __forceinline__ unsigned xb_xcc_id() { return (unsigned)__builtin_amdgcn_s_getreg((3 << 11) | 20) & 0xFu; }
#define XB_SPIN(cond, bar) do { unsigned _sp = 0; while (cond) { __builtin_amdgcn_s_sleep(1); \
    if ((++_sp & 255u) == 0u) { if (xb_ld(&(bar)[XB_TMO])) break; if (_sp > XB_SPIN_CAP) { atomicAdd(&(bar)[XB_TMO], 1u); break; } } } } while (0)

struct XcdBarrier {
    unsigned* bar; unsigned x;
    volatile LAS unsigned* st;
};

__device__ __forceinline__ XcdBarrier xcd_barrier_post(unsigned* bar, volatile LAS unsigned* st) {
    XcdBarrier b; b.bar = bar; b.x = xb_xcc_id(); b.st = st;
    if (threadIdx.x == 0) (void)xb_add(&bar[XB_XCNT(b.x)], 1u);
    return b;
}
__device__ __forceinline__ void xcd_barrier_complete(unsigned* bar, unsigned x, unsigned& nloc, unsigned& nx) {
    const unsigned G = gridDim.x * gridDim.y * gridDim.z;
    unsigned sum, cnt, mine, sp = 0u;
    for (;;) {
        sum = 0u; cnt = 0u; mine = 0u;
#pragma unroll
        for (unsigned j = 0; j < 16; ++j) { const unsigned c = xb_ld(&bar[XB_XCNT(j)]); sum += c; cnt += (c > 0u) ? 1u : 0u; mine = (j == x) ? c : mine; }
        if (sum == G) break;
        __builtin_amdgcn_s_sleep(1);
        if ((++sp & 255u) == 0u) { if (xb_ld(&bar[XB_TMO])) break; if (sp > XB_SPIN_CAP) { atomicAdd(&bar[XB_TMO], 1u); break; } }
    }
    nloc = mine > 0u ? mine : 1u; nx = cnt > 0u ? cnt : 1u;
}

__device__ __forceinline__ void xcd_barrier(const XcdBarrier& b) {
    asm volatile("s_waitcnt vmcnt(0)" ::: "memory");
    __syncthreads();
    if (threadIdx.x == 0) {
        unsigned* bar = b.bar;
        __builtin_amdgcn_s_waitcnt(0);
        unsigned nloc = b.st[0], nx = b.st[1];
        if (nloc == 0u) { xcd_barrier_complete(bar, b.x, nloc, nx); b.st[0] = nloc; b.st[1] = nx; }
        const unsigned old = xb_add(&bar[XB_XSUB(b.x)], 1u);
        const unsigned gen = old / nloc;
        if (old + 1u == (gen + 1u) * nloc) {
            __builtin_amdgcn_fence(__ATOMIC_RELEASE, "agent");
            asm volatile("s_waitcnt vmcnt(0)" ::: "memory");
            const unsigned og = xb_add(&bar[XB_TOP], 1u);
            const unsigned tg = og / nx;
            if (og + 1u == (tg + 1u) * nx) xb_add(&bar[XB_TOPGEN], 1u);
            else XB_SPIN(xb_ld(&bar[XB_TOPGEN]) == tg, bar);
            __builtin_amdgcn_fence(__ATOMIC_ACQUIRE, "agent");
            xb_add(&bar[XB_XGEN(b.x)], 1u);
            asm volatile("s_waitcnt vmcnt(0)" ::: "memory");
        } else {
            XB_SPIN(xb_ld(&bar[XB_XGEN(b.x)]) == gen, bar);
            __builtin_amdgcn_fence(__ATOMIC_ACQUIRE, "agent");
            asm volatile("s_waitcnt vmcnt(0)" ::: "memory");
        }
    }
    __syncthreads();
}

namespace pg8 {
constexpr int BM = 256, BK = 64, HALF = 128, HTB = HALF * BK * 2, STAGE_BYTES = 8 * HTB;
__host__ __device__ __forceinline__ int lds_byte(int r, int c) { const int st = (r >> 4) * 2 + (c >> 5), rr = r & 15, cc = c & 31, ob = rr * 64 + cc * 2; return st * 1024 + (ob ^ (((ob >> 9) & 1) << 5)); }
__host__ __device__ __forceinline__ void stage_rc(int b, int& R, int& C) { const int st = b / 1024, sb = b % 1024, swz = sb ^ (((sb >> 9) & 1) << 5); R = (st >> 1) * 16 + swz / 64; C = (st & 1) * 32 + (swz % 64) / 2; }
__host__ __device__ __forceinline__ int perm32(int rho) { const int n = rho >> 4, i = rho & 15; return 8 * (i >> 2) + 4 * n + (i & 3); }

struct Unit {
    const char* A;
    const char* B;
    const int* idx;
    int row0;
    int tile, pn, kind, e;
    int slot;
    int sameA;
};
__device__ __forceinline__ void glds16m(const char* sbase, unsigned voff, unsigned lds_dst, int msk) {
    unsigned keep;
    asm volatile("s_mov_b32 %0, m0\n\ts_mov_b32 m0, %3\n\ts_mov_b32 exec_lo, %4\n\ts_mov_b32 exec_hi, %4\n\ts_nop 0\n\tglobal_load_lds_dwordx4 %1, %2\n\ts_mov_b64 exec, -1\n\ts_mov_b32 m0, %0"
                 : "=&s"(keep) : "v"(voff), "s"(sbase), "s"(lds_dst), "s"(msk) : "memory");
}

typedef int v8i32 __attribute__((ext_vector_type(8)));
template <class Epi, class Sched, bool GATHER, bool ALIGN_EPI, bool FP8 = false, bool SKIPA = false>
__device__ __forceinline__ void gemm_phase(LAS unsigned char* lds, const int K_, const Sched& S, const Epi& E) {
    int K = K_; asm volatile("" : "+s"(K));
    const int tid = threadIdx.x, wid = __builtin_amdgcn_readfirstlane(tid >> 6), lane = tid & 63, wr = wid >> 2, wc = wid & 3, fr = lane & 15, fq = lane >> 4;
    const int nt = K / BK;
    unsigned voffA[2], voffB[2];
#pragma unroll
    for (int i = 0; i < 2; ++i) { int R, C; stage_rc(tid * 16 + i * 8192, R, C); const int Rb = Epi::PERM ? ((R & ~31) + perm32(R & 31)) : R;
        voffA[i] = (unsigned)(R * K + C) * 2u; voffB[i] = (unsigned)(Rb * K + C) * 2u; }
    const size_t kstep = (size_t)(BK * 2);
    const size_t hstep = (size_t)HALF * K * 2;
    const unsigned ldsw = (unsigned)wid * 1024u, lds0 = (unsigned)(uintptr_t)lds;
    const int aoff = lds_byte(wr * 64 + fr, fq * 8), boff = lds_byte(wc * 32 + fr, fq * 8);
#define PG8_SA(b, h) (((b) * 2 + (h)) * HTB)
#define PG8_SB(b, h) ((4 + (b) * 2 + (h)) * HTB)
#define PG8_STAGE(bufoff, gbase, voff) do { _Pragma("unroll") for (int _i = 0; _i < 2; ++_i) \
        __builtin_amdgcn_global_load_lds((const unsigned*)((const char*)(gbase) + (voff)[_i]), (LAS unsigned*)(lds + (bufoff) + ldsw + _i * 8192), 16, 0, 0); } while (0)
#define PG8_STAGE_A(bufoff, p, h, OA) do { if constexpr (GATHER) { PG8_STAGE(bufoff, p, OA[h]); } else { PG8_STAGE(bufoff, (p) + (h) * hstep, voffA); } } while (0)
#define PG8_STAGE_AM(bufoff, p, h, OA, msk) do { if constexpr (SKIPA) { _Pragma("unroll") for (int _i = 0; _i < 2; ++_i) \
        glds16m((const char*)(p), OA[h][_i], (unsigned)__builtin_amdgcn_readfirstlane((int)(lds0 + (bufoff) + ldsw + _i * 8192)), __builtin_amdgcn_readfirstlane(msk)); } else { PG8_STAGE_A(bufoff, p, h, OA); } } while (0)
#define PG8_LD8(p) ({ const u32x4 lo_ = *(const LAS u32x4*)(p), hi_ = *(const LAS u32x4*)((p) + 1024); (v8i32){(int)lo_.x, (int)lo_.y, (int)lo_.z, (int)lo_.w, (int)hi_.x, (int)hi_.y, (int)hi_.z, (int)hi_.w}; })
#define PG8_LDA(dst, b, h) do { if constexpr (FP8) { _Pragma("unroll") for (int m = 0; m < 4; ++m) dst##8[m] = PG8_LD8(lds + PG8_SA(b, h) + aoff + m * 2048); } \
        else { _Pragma("unroll") for (int m = 0; m < 4; ++m) _Pragma("unroll") for (int k = 0; k < 2; ++k) dst[m][k] = *(const LAS bf16x8*)(lds + PG8_SA(b, h) + aoff + m * 2048 + k * 1024); } } while (0)
#define PG8_LDB(dst, b, h) do { if constexpr (FP8) { _Pragma("unroll") for (int n = 0; n < 2; ++n) dst##8[n] = PG8_LD8(lds + PG8_SB(b, h) + boff + n * 2048); } \
        else { _Pragma("unroll") for (int n = 0; n < 2; ++n) _Pragma("unroll") for (int k = 0; k < 2; ++k) dst[n][k] = *(const LAS bf16x8*)(lds + PG8_SB(b, h) + boff + n * 2048 + k * 1024); } } while (0)
#define PG8_MMA(ai, bj, At, Bt) do { __builtin_amdgcn_s_setprio(1); if constexpr (FP8) { _Pragma("unroll") for (int m = 0; m < 4; ++m) _Pragma("unroll") for (int n = 0; n < 2; ++n) \
            acc[ai][bj][m][n] = __builtin_amdgcn_mfma_scale_f32_16x16x128_f8f6f4(Bt##8[n], At##8[m], acc[ai][bj][m][n], 0, 0, 0, 0x7F7F7F7F, 0, 0x7F7F7F7F); } \
        else { _Pragma("unroll") for (int m = 0; m < 4; ++m) _Pragma("unroll") for (int n = 0; n < 2; ++n) _Pragma("unroll") for (int k = 0; k < 2; ++k) \
            acc[ai][bj][m][n] = __builtin_amdgcn_mfma_f32_16x16x32_bf16(Bt[n][k], At[m][k], acc[ai][bj][m][n], 0, 0, 0); } __builtin_amdgcn_s_setprio(0); } while (0)
#define PG8_WAIT_V(n) asm volatile("s_waitcnt vmcnt(" #n ")" ::: "memory")
#define PG8_WAIT_L(n) asm volatile("s_waitcnt lgkmcnt(" #n ")" ::: "memory")
#define PG8_BAR __builtin_amdgcn_s_barrier()
#define PG8_SCHED __builtin_amdgcn_sched_barrier(0)
#define PG8_ROWOFF(U, OA) do { if constexpr (GATHER) { int tl_ = tid; asm volatile("" : "+v"(tl_)); const LAS int* li_ = (const LAS int*)(lds + Sched::SIDE_OFF + (U).slot * 1024); \
        _Pragma("unroll") for (int _i = 0; _i < 2; ++_i) { int R_, C_; stage_rc(tl_ * 16 + _i * 8192, R_, C_); \
        _Pragma("unroll") for (int _h = 0; _h < 2; ++_h) { const int _r = _h * HALF + R_; const int _src = (U).idx ? li_[_r] : (U).row0 + _r; OA[_h][_i] = (unsigned)(_src * K + C_) * 2u; } } } } while (0)
    Unit cur, nxt; int ui = 0;
    if (!S.next(0, cur)) return;
    f32x4 acc[2][2][4][2];
#pragma unroll
    for (int a = 0; a < 2; ++a)
#pragma unroll
        for (int b = 0; b < 2; ++b)
#pragma unroll
            for (int m = 0; m < 4; ++m)
#pragma unroll
                for (int n = 0; n < 2; ++n) acc[a][b][m][n] = (f32x4){0.f, 0.f, 0.f, 0.f};
    bf16x8 At[4][2], B0[2][2], B1[2][2]; v8i32 At8[4], B08[2], B18[2];
    unsigned oA[2][2] = {{0u, 0u}, {0u, 0u}};
    const char* cA = cur.A; const char* cB = cur.B;
    cur.slot = 0; S.prefetch(cur, lds, wid, lane);
    if constexpr (GATHER) { asm volatile("s_waitcnt vmcnt(0)" ::: "memory"); __builtin_amdgcn_s_barrier(); asm volatile("" ::: "memory"); }
    PG8_ROWOFF(cur, oA);
    PG8_STAGE(PG8_SB(0, 0), cB, voffB); PG8_STAGE(PG8_SB(0, 1), cB + hstep, voffB); PG8_STAGE_A(PG8_SA(0, 0), cA, 0, oA); PG8_STAGE_A(PG8_SA(0, 1), cA, 1, oA);
    if (wr == 1) PG8_BAR;
    PG8_WAIT_V(2); PG8_BAR;
    PG8_STAGE(PG8_SB(1, 0), cB + kstep, voffB); PG8_STAGE_A(PG8_SA(1, 0), cA + kstep, 0, oA); PG8_STAGE(PG8_SB(1, 1), cB + hstep + kstep, voffB);
    PG8_WAIT_V(6); PG8_BAR;
    for (;;) {
        const bool has_next = S.next(ui + 1, nxt);
        if (has_next) { nxt.slot = (ui + 1) % 3; S.prefetch(nxt, lds, wid, lane); }
        const char* nA = has_next ? nxt.A : cA; const char* nB = has_next ? nxt.B : cB;
        const int cmsk = __builtin_amdgcn_readfirstlane((SKIPA && ui > 0 && cur.sameA) ? 0 : -1), nmsk = __builtin_amdgcn_readfirstlane((SKIPA && has_next && nxt.sameA) ? 0 : -1);
#pragma unroll 1
        for (int t = 0; t < nt; t += 2) {
            const bool last = (t == nt - 2);
            const char* a1 = cA + (size_t)(t + 1) * kstep;
            const char* a2 = last ? nA : cA + (size_t)(t + 2) * kstep; const char* b2 = last ? nB : cB + (size_t)(t + 2) * kstep;
            const char* a3 = a2 + kstep; const char* b3 = b2 + kstep;
            PG8_LDB(B0, 0, 0); PG8_LDB(B1, 0, 1); PG8_SCHED; PG8_LDA(At, 0, 0); PG8_STAGE_AM(PG8_SA(1, 1), a1, 1, oA, cmsk);
            if constexpr (GATHER) { if (last && has_next) { PG8_ROWOFF(nxt, oA); } }
            PG8_WAIT_V(8); PG8_WAIT_L(0); PG8_BAR; PG8_MMA(0, 0, At, B0); PG8_MMA(0, 1, At, B1); PG8_BAR; PG8_SCHED;
            PG8_LDA(At, 0, 1); PG8_STAGE(PG8_SB(0, 0), b2, voffB); PG8_STAGE(PG8_SB(0, 1), b2 + hstep, voffB); PG8_STAGE_AM(PG8_SA(0, 0), a2, 0, oA, (last ? nmsk : cmsk));
            PG8_WAIT_V(8); PG8_WAIT_L(0); PG8_BAR; PG8_MMA(1, 0, At, B0); PG8_MMA(1, 1, At, B1); PG8_BAR; PG8_SCHED;
            PG8_LDB(B0, 1, 0); PG8_LDB(B1, 1, 1); PG8_SCHED; PG8_LDA(At, 1, 0); PG8_STAGE_AM(PG8_SA(0, 1), a2, 1, oA, (last ? nmsk : cmsk));
            PG8_WAIT_V(8); PG8_WAIT_L(0); PG8_BAR; PG8_MMA(0, 0, At, B0); PG8_MMA(0, 1, At, B1); PG8_BAR; PG8_SCHED;
            PG8_LDA(At, 1, 1); PG8_STAGE(PG8_SB(1, 0), b3, voffB); PG8_STAGE(PG8_SB(1, 1), b3 + hstep, voffB); PG8_STAGE_AM(PG8_SA(1, 0), a3, 0, oA, (last ? nmsk : cmsk));
            PG8_WAIT_V(8); PG8_WAIT_L(0); PG8_BAR; PG8_MMA(1, 0, At, B0); PG8_MMA(1, 1, At, B1); PG8_BAR; PG8_SCHED;
        }
        if constexpr (ALIGN_EPI) { if (wr == 0) PG8_BAR; }
        if constexpr (!Epi::AFTER_DRAIN) E(acc, cur, wr, wc, fr, fq);
        if (!has_next) break;
#pragma unroll
        for (int a = 0; a < 2; ++a)
#pragma unroll
            for (int b = 0; b < 2; ++b)
#pragma unroll
                for (int m = 0; m < 4; ++m)
#pragma unroll
                    for (int n = 0; n < 2; ++n) acc[a][b][m][n] = (f32x4){0.f, 0.f, 0.f, 0.f};
        cur = nxt; cA = nA; cB = nB; ++ui;
        if constexpr (ALIGN_EPI) { if (wr == 1) PG8_BAR; }
    }
    PG8_WAIT_V(0);
    if constexpr (!ALIGN_EPI) { if (wr == 0) PG8_BAR; }
    PG8_BAR;
    if constexpr (Epi::AFTER_DRAIN) E.fused(acc, cur, wr, wc, fr, fq, lds);
#undef PG8_SA
#undef PG8_SB
#undef PG8_STAGE
#undef PG8_STAGE_A
#undef PG8_STAGE_AM
#undef PG8_LDA
#undef PG8_LD8
#undef PG8_LDB
#undef PG8_MMA
#undef PG8_WAIT_V
#undef PG8_WAIT_L
#undef PG8_BAR
#undef PG8_SCHED
#undef PG8_ROWOFF
}
}

using pg8::Unit;
typedef f32x4 AccT[2][2][4][2];
constexpr int DN_SIDE = MISC_OFF;
constexpr int DN_STAGE = MISC_OFF + 4096;

struct EpiDenseBf16 {
    static constexpr bool PERM = true, AFTER_DRAIN = false;
    bf16_t* O; int ldc; int slo, shi; float s; float base;
    __device__ __forceinline__ void operator()(const AccT& acc, const Unit& u, int wr, int wc, int fr, int fq) const {
        const float sc = ((u.pn >= slo && u.pn < shi) ? s : 1.f) * base;
        const int row0 = u.tile * 256 + wr * 64 + fr, col0 = u.pn * 256 + wc * 32 + 8 * fq;
#pragma unroll
        for (int ai = 0; ai < 2; ++ai)
#pragma unroll
            for (int m = 0; m < 4; ++m) { bf16_t* rowp = O + (size_t)(row0 + ai * 128 + m * 16) * ldc + col0;
#pragma unroll
                for (int bj = 0; bj < 2; ++bj) { const f32x4 v0 = acc[ai][bj][m][0] * sc, v1 = acc[ai][bj][m][1] * sc;
                    u32x4 w; w.x = cvt_pk_bf16(v0[0], v0[1]); w.y = cvt_pk_bf16(v0[2], v0[3]); w.z = cvt_pk_bf16(v1[0], v1[1]); w.w = cvt_pk_bf16(v1[2], v1[3]);
                    *(u32x4*)(rowp + bj * 128) = w; } }
    }
};
struct EpiLogits {
    static constexpr bool PERM = false, AFTER_DRAIN = false;
    float* C;
    __device__ __forceinline__ void operator()(const AccT& acc, const Unit& u, int wr, int wc, int fr, int fq) const {
        const int row0 = u.tile * 256 + wr * 64 + fr, col0 = wc * 32 + 4 * fq;
#pragma unroll
        for (int ai = 0; ai < 2; ++ai)
#pragma unroll
            for (int m = 0; m < 4; ++m) { float* rowp = C + (size_t)(row0 + ai * 128 + m * 16) * 256 + col0;
#pragma unroll
                for (int bj = 0; bj < 2; ++bj)
#pragma unroll
                    for (int n = 0; n < 2; ++n) *(f32x4*)(rowp + bj * 128 + n * 16) = acc[ai][bj][m][n]; }
    }
};
__device__ __forceinline__ char* h_tile_ptr(char* dout, char*, int hidx) { return dout + (size_t)hidx * 65536; }
struct EpiGateUp {
    static constexpr bool PERM = true, AFTER_DRAIN = false;
    char* dout; char* wsht;
    __device__ __forceinline__ void operator()(const AccT& acc, const Unit& u, int wr, int wc, int fr, int fq) const {
        unsigned char* Ht = (unsigned char*)h_tile_ptr(dout, wsht, u.tile);
        const int row0 = wr * 64 + fr, col0 = u.pn * 128 + wc * 32 + 8 * fq;
        constexpr float KE = -LOG2E / WSCALE, CI = WSCALE * WSCALE / HSCALE, LC = 10.f;
        static_assert(CI == 1024.f, "scale");
#pragma unroll
        for (int ai = 0; ai < 2; ++ai)
#pragma unroll
            for (int m = 0; m < 4; ++m) {
                float hv[8];
#pragma unroll
                for (int n = 0; n < 2; ++n)
#pragma unroll
                    for (int j = 0; j < 4; ++j) { const float ga = acc[ai][0][m][n][j], ua = acc[ai][1][m][n][j];
                        hv[n * 4 + j] = (ga * ua) * __builtin_amdgcn_rcpf(__builtin_amdgcn_exp2f(__builtin_fmaf(ga, KE, LC)) + CI); }
                u32x2 w; w.x = pk4_fp8(hv[0], hv[1], hv[2], hv[3]); w.y = pk4_fp8(hv[4], hv[5], hv[6], hv[7]);
                *(u32x2*)(Ht + (size_t)(row0 + ai * 128 + m * 16) * 256 + col0) = w; }
    }
};
template <bool SHARED> struct EpiDown {
    static constexpr bool PERM = true, AFTER_DRAIN = false;
    unsigned char* Y; bf16_t* X1; const float* modf; LAS unsigned char* lds;
    __device__ __forceinline__ void operator()(const AccT& acc, const Unit& u, int wr, int wc, int fr, int fq) const {
        asm volatile("" : "+v"(fr), "+v"(fq));
        const int r0 = wr * 64 + fr, c0 = u.pn * 256 + wc * 64 + 8 * fq;
        if constexpr (!SHARED) {
            const LAS float* wp = (const LAS float*)(lds + DN_SIDE + u.slot * 1024) + r0;
            const int lane_ = fq * 16 + fr;
            LAS unsigned char* st = lds + DN_STAGE + (wr * 4 + wc) * 1280;
            unsigned char* yb = Y + ((size_t)u.e + wr * 64 + (lane_ >> 2)) * 1024 + u.pn * 256 + wc * 64 + (lane_ & 3) * 16;
#pragma unroll
            for (int ai = 0; ai < 2; ++ai)
#pragma unroll
                for (int m = 0; m < 4; ++m) { const float w = wp[ai * 128 + m * 16] * (YSCALE / (WSCALE * HSCALE));
#pragma unroll
                    for (int bj = 0; bj < 2; ++bj) { const f32x4 v0 = acc[ai][bj][m][0] * w, v1 = acc[ai][bj][m][1] * w;
                        int p0 = __builtin_amdgcn_cvt_pk_fp8_f32(v0[0], v0[1], 0, false); p0 = __builtin_amdgcn_cvt_pk_fp8_f32(v0[2], v0[3], p0, true);
                        int p1 = __builtin_amdgcn_cvt_pk_fp8_f32(v1[0], v1[1], 0, false); p1 = __builtin_amdgcn_cvt_pk_fp8_f32(v1[2], v1[3], p1, true);
                        u32x2 pk; pk.x = (unsigned)p0; pk.y = (unsigned)p1;
                        *(LAS u32x2*)(st + fr * 80 + bj * 32 + 8 * fq) = pk; }
                    const u32x4 o = *(const LAS u32x4*)(st + (lane_ >> 2) * 80 + (lane_ & 3) * 16);
                    *(u32x4*)(yb + (size_t)(ai * 128 + m * 16) * 1024) = o; }
        } else {
            const int trow0 = u.e + r0;
            const float* g2 = modf + (size_t)(u.e >> 11) * 6144 + 5120 + c0;
#pragma unroll
            for (int bj = 0; bj < 2; ++bj) {
                const f32x4 ga = *(const f32x4*)(g2 + bj * 32) * (1.f / (WSCALE * HSCALE)), gb = *(const f32x4*)(g2 + bj * 32 + 4) * (1.f / (WSCALE * HSCALE));
#pragma unroll
                for (int ai = 0; ai < 2; ++ai)
#pragma unroll
                    for (int m = 0; m < 4; ++m) { bf16_t* p = X1 + (size_t)(trow0 + ai * 128 + m * 16) * DM + c0 + bj * 32;
                        const u32x4 o = *(const u32x4*)p; const f32x4 v0 = acc[ai][bj][m][0], v1 = acc[ai][bj][m][1];
                        u32x4 w;
                        w.x = cvt_pk_bf16(bf_lo(o.x) + ga[0] * v0[0], bf_hi(o.x) + ga[1] * v0[1]); w.y = cvt_pk_bf16(bf_lo(o.y) + ga[2] * v0[2], bf_hi(o.y) + ga[3] * v0[3]);
                        w.z = cvt_pk_bf16(bf_lo(o.z) + gb[0] * v1[0], bf_hi(o.z) + gb[1] * v1[1]); w.w = cvt_pk_bf16(bf_lo(o.w) + gb[2] * v1[2], bf_hi(o.w) + gb[3] * v1[3]);
                        *(u32x4*)p = w; } }
        }
    }
};

struct DenseOrder {
    static constexpr int SIDE_OFF = MISC_OFF;
    const char* A; const char* Bt; int nM, nN, nwg, G, c; size_t tstep; int ioff = 0, imax = 1 << 30; int gmode = 0;
    __device__ __forceinline__ void prefetch(const Unit&, LAS unsigned char*, int, int) const {}
    __device__ __forceinline__ void init(const void* A_, const void* Bt_, int M, int N, int K, int G_, int c_) { A = (const char*)A_; Bt = (const char*)Bt_; nM = M / 256; nN = N / 256; nwg = nM * nN; G = G_; c = c_; tstep = (size_t)256 * K * 2; }
    __device__ __forceinline__ bool next(int i, Unit& u) const {
        if (i >= imax) return false;
        const long L = (long)(i + ioff) * G + c; if (L >= nwg) return false;
        int wgid = (int)L; { const int q = nwg / 8, r = nwg % 8, xcd = wgid % 8, off = wgid / 8; wgid = (xcd < r ? xcd * (q + 1) : r * (q + 1) + (xcd - r) * q) + off; }
        const int nig = 8 * nN, gid = wgid / nig, fm = gid * 8, gsz = (nM - fm) < 8 ? (nM - fm) : 8;
        const int pm = fm + ((wgid % nig) % gsz), pn = (wgid % nig) / gsz;
        u.A = gmode ? A : A + (size_t)pm * tstep; u.B = Bt + (size_t)pn * tstep; u.idx = nullptr; u.row0 = gmode ? pm * 256 : 0; u.tile = pm; u.pn = pn; u.kind = 0; u.e = 0; return true;
    }
};
struct OneUnit {
    static constexpr int SIDE_OFF = MISC_OFF;
    const char* A; const char* Bt; int pm;
    __device__ __forceinline__ void prefetch(const Unit&, LAS unsigned char*, int, int) const {}
    __device__ __forceinline__ bool next(int i, Unit& u) const {
        if (i > 0) return false;
        u.A = A + (size_t)pm * 256 * DM * 2; u.B = Bt; u.idx = nullptr; u.row0 = 0; u.tile = pm; u.pn = 0; u.kind = 0; u.e = 0; return true;
    }
};
typedef const __attribute__((address_space(4))) int* cint_p;
struct GateUpOrder {
    static constexpr int SIDE_OFF = MISC_OFF;
    const char* h2; const char* wgu; const char* wsgu; const int* stok; const int* tile_e; int T, G, vcu;
    __device__ __forceinline__ void prefetch(const Unit& u, LAS unsigned char* lds, int wid, int lane) const {
        if (wid == 0 && u.idx) __builtin_amdgcn_global_load_lds((const unsigned*)(u.idx + lane * 4), (LAS unsigned*)(lds + SIDE_OFF + u.slot * 1024), 16, 0, 0);
    }
    __device__ __forceinline__ bool next(int i, Unit& u) const {
        const int v = i * G + vcu; if (v >= 2 * (T + 256)) return false;
        const int tile = v >> 1, half = v & 1;
        u.A = h2; u.pn = half; u.kind = 0; u.row0 = 0;
        if (tile < T) { const int e = ((cint_p)tile_e)[tile]; u.e = e; u.B = wgu + ((size_t)e * 512 + half * 256) * DM; u.idx = stok + (size_t)tile * 256; u.tile = tile; }
        else { const int j = tile - T; u.e = 0; u.B = wsgu + (size_t)half * 256 * DM; u.idx = nullptr; u.row0 = j * 256; u.tile = H_SHARED0 + j; }
        return true;
    }
};
struct DownOrder {
    static constexpr int SIDE_OFF = MISC_OFF;
    char* dout; char* wsht; const char* wd; const char* wsd; const int* tile_e; const int* sdst; const float* sw; int T, G, vcu; int shared;
    __device__ __forceinline__ void prefetch(const Unit& u, LAS unsigned char* lds, int wid, int lane) const {
        if (wid == 0 && u.kind == 0) {
            __builtin_amdgcn_global_load_lds((const unsigned*)(sw + (size_t)u.e + lane * 4), (LAS unsigned*)(lds + DN_SIDE + u.slot * 1024), 16, 0, 0);
        }
    }
    int nx, j, lo, R, rem, q0, q1;
    __device__ __forceinline__ void plan() {
        const int NT = shared ? 256 : T; nx = G >> 3; const int x = vcu / nx; j = vcu - x * nx;
        lo = (x * NT) >> 3; const int n = (((x + 1) * NT) >> 3) - lo; R = n / nx; rem = n - R * nx; q0 = (j * 4 * rem) / nx; q1 = ((j + 1) * 4 * rem) / nx;
    }
    __device__ __forceinline__ bool next(int i, Unit& u) const {
        int tl, pn, same;
        if (i < 4 * R) { tl = lo + j + nx * (i >> 2); pn = i & 3; same = pn != 0; }
        else { const int k = i - 4 * R, q = q0 + k; if (q >= q1) return false; tl = lo + nx * R + (q >> 2); pn = q & 3; same = (k > 0) && (pn != 0); }
        const int tile = tl + (shared ? T : 0);
        u.idx = nullptr; u.pn = pn; u.A = dout; u.sameA = same;
        if (tile < T) { const int e = ((cint_p)tile_e)[tile]; u.kind = 0; u.tile = tile; u.row0 = tile * 256; u.e = tile * 256; u.B = wd + ((size_t)e * 1024 + pn * 256) * EDIM; }
        else { const int j = tile - T; u.kind = 1; u.tile = H_SHARED0 + j; u.row0 = (H_SHARED0 + j) * 256; u.e = j * 256; u.B = wsd + (size_t)pn * 256 * EDIM; }
        return true;
    }
};

__device__ __forceinline__ void p0_mod_item(const float* c, const float* w_ada, float* modp, int item, int lane) {
    const int cb = item >> 2, kc = item & 3, r = lane & 31, hh = lane >> 5;
    f32x16 acc;
#pragma unroll
    for (int i = 0; i < 16; ++i) acc[i] = 0.f;
    const float* wp = w_ada + (size_t)(kc * 256 + hh) * 6144 + cb * 32 + r;
    const float* cp = c + (size_t)r * DM + kc * 256 + hh;
#pragma unroll 8
    for (int s = 0; s < 128; ++s) {
        const float a = wp[(size_t)(2 * s) * 6144];
        const float cv = cp[2 * s];
        const float b = cv * sigmoid_exact(cv);
        acc = __builtin_amdgcn_mfma_f32_32x32x2f32(a, b, acc, 0, 0, 0);
    }
    float* op = modp + ((size_t)kc * NB + r) * 6144 + cb * 32;
#pragma unroll
    for (int g = 0; g < 4; ++g) *(f32x4*)(op + 8 * g + 4 * hh) = (f32x4){acc[4 * g], acc[4 * g + 1], acc[4 * g + 2], acc[4 * g + 3]};
}
__device__ __forceinline__ void p0_tr_tile(const float* W, int N, int k0, int n0, bf16_t* WT, int ldt, int drow0, LAS unsigned char* scr, int lane, int hi_off = 0) {
    const int g = lane >> 4, nl = lane & 15;
    const float* src = W + (size_t)(k0 + 16 * g) * N + n0 + 4 * nl;
    f32x4 v[16];
#pragma unroll
    for (int i = 0; i < 16; ++i) v[i] = *(const f32x4*)(src + (size_t)i * N);
#pragma unroll
    for (int j = 0; j < 4; ++j) {
        u32x4 lo, hi;
        lo.x = cvt_pk_bf16(v[0][j], v[1][j]); lo.y = cvt_pk_bf16(v[2][j], v[3][j]); lo.z = cvt_pk_bf16(v[4][j], v[5][j]); lo.w = cvt_pk_bf16(v[6][j], v[7][j]);
        hi.x = cvt_pk_bf16(v[8][j], v[9][j]); hi.y = cvt_pk_bf16(v[10][j], v[11][j]); hi.z = cvt_pk_bf16(v[12][j], v[13][j]); hi.w = cvt_pk_bf16(v[14][j], v[15][j]);
        LAS unsigned char* p = scr + (4 * nl + j) * 144 + 32 * g;
        *(LAS u32x4*)p = lo; *(LAS u32x4*)(p + 16) = hi;
    }
    LDS_WAIT(); asm volatile("" ::: "memory");
#pragma unroll
    for (int i = 0; i < 8; ++i) { const int row = (lane >> 3) + 8 * i, ch = lane & 7;
        const u32x4 o = *(const LAS u32x4*)(scr + row * 144 + ch * 16);
        *(u32x4*)(WT + (size_t)(drow0 + row + (row >= 32 ? hi_off : 0)) * ldt + k0 + ch * 8) = o; }
    LDS_WAIT(); asm volatile("" ::: "memory");
}
__device__ __forceinline__ void p0_tr_tile8(const float* W, int N, int k0, int n0, unsigned char* WT, int ldt, int drow0, LAS unsigned char* scr, int lane, int hi_off = 0) {
    const int g = lane >> 4, nl = lane & 15;
    const float* src = W + (size_t)(k0 + 32 * g) * N + n0 + 4 * nl;
    f32x4 v[32];
#pragma unroll
    for (int i = 0; i < 32; ++i) v[i] = *(const f32x4*)(src + (size_t)i * N);
#pragma unroll
    for (int j = 0; j < 4; ++j) {
        u32x4 o0, o1;
        o0.x = pk4_fp8(v[0][j] * WSCALE, v[1][j] * WSCALE, v[2][j] * WSCALE, v[3][j] * WSCALE); o0.y = pk4_fp8(v[4][j] * WSCALE, v[5][j] * WSCALE, v[6][j] * WSCALE, v[7][j] * WSCALE);
        o0.z = pk4_fp8(v[8][j] * WSCALE, v[9][j] * WSCALE, v[10][j] * WSCALE, v[11][j] * WSCALE); o0.w = pk4_fp8(v[12][j] * WSCALE, v[13][j] * WSCALE, v[14][j] * WSCALE, v[15][j] * WSCALE);
        o1.x = pk4_fp8(v[16][j] * WSCALE, v[17][j] * WSCALE, v[18][j] * WSCALE, v[19][j] * WSCALE); o1.y = pk4_fp8(v[20][j] * WSCALE, v[21][j] * WSCALE, v[22][j] * WSCALE, v[23][j] * WSCALE);
        o1.z = pk4_fp8(v[24][j] * WSCALE, v[25][j] * WSCALE, v[26][j] * WSCALE, v[27][j] * WSCALE); o1.w = pk4_fp8(v[28][j] * WSCALE, v[29][j] * WSCALE, v[30][j] * WSCALE, v[31][j] * WSCALE);
        LAS unsigned char* p = scr + (4 * nl + j) * 144 + 32 * g;
        *(LAS u32x4*)p = o0; *(LAS u32x4*)(p + 16) = o1;
    }
    LDS_WAIT(); asm volatile("" ::: "memory");
#pragma unroll
    for (int i = 0; i < 8; ++i) { const int row = (lane >> 3) + 8 * i, ch = lane & 7;
        const u32x4 o = *(const LAS u32x4*)(scr + row * 144 + ch * 16);
        *(u32x4*)(WT + (size_t)(drow0 + row + (row >= 32 ? hi_off : 0)) * ldt + k0 + ch * 16) = o; }
    LDS_WAIT(); asm volatile("" ::: "memory");
}
constexpr int P0_N_MOD = 768, P0_N_SMALL = 512 + 256 + 64 + 32 + 32 + 32 + 16, P0_N_EXP = 96 * NEXP;
struct TileDesc { const float* src; unsigned char* dst; int N, ldt, hi_off; };
__device__ __forceinline__ TileDesc p0_expert_tile(const float* w_gate, const float* w_up, const float* w_down, unsigned char* ws, int item, int lane) {
    const int e = item / 96, q = item % 96, g = lane >> 4, nl = lane & 15;
    TileDesc d;
    if (q < 64) { const int qq = q & 31, n0 = 64 * (qq & 3), k0 = 128 * (qq >> 2); const float* W = (q < 32 ? w_gate : w_up) + (size_t)e * DM * EDIM;
        d.N = EDIM; d.ldt = DM; d.hi_off = 0; d.src = W + (size_t)(k0 + 16 * g) * EDIM + n0 + 4 * nl;
        d.dst = ws + WS_WGU + ((size_t)e * 512 + (n0 >> 7) * 256 + (q < 32 ? 0 : 128) + (n0 & 127)) * DM + k0; }
    else { const int qq = q - 64, n0 = 64 * (qq & 15), k0 = 128 * (qq >> 4); const float* W = w_down + (size_t)e * EDIM * DM;
        d.N = DM; d.ldt = EDIM; d.hi_off = 96; d.src = W + (size_t)(k0 + 16 * g) * DM + n0 + 4 * nl;
        d.dst = ws + WS_WD + ((size_t)e * DM + (n0 & ~255) + 32 * ((n0 & 255) >> 6)) * EDIM + k0; }
    return d;
}
#define P0_LOAD_HALF(v, d, half) do { _Pragma("unroll") for (int i_ = 0; i_ < 16; ++i_) v[i_] = *(const f32x4*)((d).src + (size_t)((half) * 64 + i_) * (d).N); } while (0)
#define P0_CVT_HALF(v, half) do { _Pragma("unroll") for (int j_ = 0; j_ < 4; ++j_) { u32x4 o_; \
        o_.x = pk4_fp8(v[0][j_] * WSCALE, v[1][j_] * WSCALE, v[2][j_] * WSCALE, v[3][j_] * WSCALE); o_.y = pk4_fp8(v[4][j_] * WSCALE, v[5][j_] * WSCALE, v[6][j_] * WSCALE, v[7][j_] * WSCALE); \
        o_.z = pk4_fp8(v[8][j_] * WSCALE, v[9][j_] * WSCALE, v[10][j_] * WSCALE, v[11][j_] * WSCALE); o_.w = pk4_fp8(v[12][j_] * WSCALE, v[13][j_] * WSCALE, v[14][j_] * WSCALE, v[15][j_] * WSCALE); \
        *(LAS u32x4*)(scr + (4 * nl + j_) * 144 + (half) * 64 + 16 * g) = o_; } } while (0)
__device__ __forceinline__ void p0_expert_stream(const float* w_gate, const float* w_up, const float* w_down, unsigned char* ws, LAS unsigned char* lds, int gw, int NGW, int wave, int lane, int it_lo, int it_hi) {
    LAS unsigned char* scr = lds + wave * 9216;
    const int g = lane >> 4, nl = lane & 15;
    int it = it_lo + gw;
    if (it >= it_hi) return;
    TileDesc cur = p0_expert_tile(w_gate, w_up, w_down, ws, it, lane);
    f32x4 va[16], vb[16];
    P0_LOAD_HALF(va, cur, 0); P0_LOAD_HALF(vb, cur, 1);
    for (;;) {
        const int nit = it + NGW; const bool more = nit < it_hi;
        TileDesc nxt = cur; if (more) nxt = p0_expert_tile(w_gate, w_up, w_down, ws, nit, lane);
        P0_CVT_HALF(va, 0);
        if (more) P0_LOAD_HALF(va, nxt, 0);
        P0_CVT_HALF(vb, 1);
        if (more) P0_LOAD_HALF(vb, nxt, 1);
        LDS_WAIT(); asm volatile("" ::: "memory");
#pragma unroll
        for (int i = 0; i < 8; ++i) { const int row = (lane >> 3) + 8 * i, ch = lane & 7;
            const u32x4 o = *(const LAS u32x4*)(scr + row * 144 + ch * 16);
            *(u32x4*)(cur.dst + (size_t)(row + (row >= 32 ? cur.hi_off : 0)) * cur.ldt + ch * 16) = o; }
        LDS_WAIT(); asm volatile("" ::: "memory");
        if (!more) break;
        cur = nxt; it = nit;
    }
}
#undef P0_LOAD_HALF
#undef P0_CVT_HALF
struct P0Ptrs { const float *c, *w_ada, *w_in, *w_out, *w_router, *ws_gate, *ws_up, *ws_down, *pool_w, *w_gate, *w_up, *w_down; unsigned char* ws; };
__device__ __forceinline__ void p0_phase(const P0Ptrs& P, LAS unsigned char* lds, int gw, int NGW, int wave, int lane) {
    LAS unsigned char* scr = lds + wave * 9216;
    unsigned char* ws = P.ws;
    constexpr int N_MOD = P0_N_MOD;
    for (int it = gw; it < P0_N_MOD + P0_N_SMALL; it += NGW) {
        int r = it;
        if (r < N_MOD) { p0_mod_item(P.c, P.w_ada, (float*)(ws + WS_MODP), r, lane); continue; } r -= N_MOD;
        if (r < 512) { if (r < 256) p0_tr_tile8(P.w_in, IND, 128 * (r >> 5), 64 * (r & 31), ws + WS_WIN, DM, 64 * (r & 31), scr, lane); continue; } r -= 512;
        if (r < 256) { if (r < 128) p0_tr_tile8(P.w_out, DM, 128 * (r >> 4), 64 * (r & 15), ws + WS_WOUT, DM, 64 * (r & 15), scr, lane); continue; } r -= 256;
        if (r < 64) { p0_tr_tile(P.w_router, NEXP, 64 * (r >> 2), 64 * (r & 3), (bf16_t*)(ws + WS_WR), DM, 64 * (r & 3), scr, lane); continue; } r -= 64;
        if (r < 32) { const int n0 = 64 * (r & 3); p0_tr_tile8(P.ws_gate, EDIM, 128 * (r >> 2), n0, ws + WS_WSGU, DM, (n0 >> 7) * 256 + (n0 & 127), scr, lane); continue; } r -= 32;
        if (r < 32) { const int n0 = 64 * (r & 3); p0_tr_tile8(P.ws_up, EDIM, 128 * (r >> 2), n0, ws + WS_WSGU, DM, (n0 >> 7) * 256 + 128 + (n0 & 127), scr, lane); continue; } r -= 32;
        if (r < 32) { const int n0 = 64 * (r & 15); p0_tr_tile8(P.ws_down, DM, 128 * (r >> 4), n0, ws + WS_WSD, EDIM, (n0 & ~255) + 32 * ((n0 & 255) >> 6), scr, lane, 96); continue; } r -= 32;
        if (r < 16) { const int g = r >> 2, q = r & 3; p0_tr_tile(P.pool_w + (size_t)g * 128 * 128, 128, 64 * (q >> 1), 64 * (q & 1), (bf16_t*)(ws + WS_WPOOL) + (size_t)g * 128 * 128, 128, 64 * (q & 1), scr, lane); continue; } r -= 16;
        const int e = r / 96, q = r % 96;
        if (q < 32) { const int n0 = 64 * (q & 3); p0_tr_tile8(P.w_gate + (size_t)e * DM * EDIM, EDIM, 128 * (q >> 2), n0, ws + WS_WGU + (size_t)e * 512 * DM, DM, (n0 >> 7) * 256 + (n0 & 127), scr, lane); }
        else if (q < 64) { const int qq = q - 32, n0 = 64 * (qq & 3); p0_tr_tile8(P.w_up + (size_t)e * DM * EDIM, EDIM, 128 * (qq >> 2), n0, ws + WS_WGU + (size_t)e * 512 * DM, DM, (n0 >> 7) * 256 + 128 + (n0 & 127), scr, lane); }
        else { const int qq = q - 64, n0 = 64 * (qq & 15); p0_tr_tile8(P.w_down + (size_t)e * EDIM * DM, DM, 128 * (qq >> 4), n0, ws + WS_WD + (size_t)e * DM * EDIM, EDIM, (n0 & ~255) + 32 * ((n0 & 255) >> 6), scr, lane, 96); }
    }
}

__device__ __forceinline__ float mod_sum(const float* modp, const float* b_ada, int b, int col) {
    const float* p = modp + (size_t)b * 6144 + col;
    return b_ada[col] + ((p[0] + p[(size_t)NB * 6144]) + (p[(size_t)2 * NB * 6144] + p[(size_t)3 * NB * 6144]));
}
__device__ __forceinline__ void p1_phase(const float* x, const float* b_ada, unsigned char* ws, int gw, int NGW, int lane, int gtid, int ngt) {
    const float* modp = (const float*)(ws + WS_MODP); float* modf = (float*)(ws + WS_MODF); unsigned char* h1 = ws + WS_BUFA;
    for (int i = gtid; i < NB * 6144; i += ngt) modf[i] = mod_sum(modp, b_ada, i / 6144, i % 6144);
    for (int blk = gw; blk < NTOK / 32; blk += NGW) {
        const int row0 = blk * 32, b = row0 >> 11;
        asm volatile("" : "+v"(lane));
        f32x4 sc[4], sh[4];
#pragma unroll
        for (int w = 0; w < 4; ++w) {
            const int col = 256 * w + 4 * lane; const float* p = modp + (size_t)b * 6144 + col; constexpr size_t PS = (size_t)NB * 6144;
            sh[w] = *(const f32x4*)(b_ada + col) + ((*(const f32x4*)p + *(const f32x4*)(p + PS)) + (*(const f32x4*)(p + 2 * PS) + *(const f32x4*)(p + 3 * PS)));
            sc[w] = 1.f + (*(const f32x4*)(b_ada + 1024 + col) + ((*(const f32x4*)(p + 1024) + *(const f32x4*)(p + 1024 + PS)) + (*(const f32x4*)(p + 1024 + 2 * PS) + *(const f32x4*)(p + 1024 + 3 * PS)))); }
        const float* xp = x + (size_t)row0 * DM + 4 * lane; unsigned char* hp = h1 + (size_t)row0 * DM + 4 * lane;
        f32x4 b0[16], b1[16];
#define P1_LOAD(dst, src) do { _Pragma("unroll") for (int i = 0; i < 16; ++i) dst[i] = *(const f32x4*)((src) + (size_t)(i >> 2) * DM + 256 * (i & 3)); } while (0)
#define P1_PUT(srcv, dstp) do { _Pragma("unroll") for (int i = 0; i < 16; ++i) { const int w = i & 3; const f32x4 a = srcv[i]; \
            *(unsigned*)((dstp) + (size_t)(i >> 2) * DM + 256 * w) = pk4_fp8(a[0] * sc[w][0] + sh[w][0], a[1] * sc[w][1] + sh[w][1], a[2] * sc[w][2] + sh[w][2], a[3] * sc[w][3] + sh[w][3]); } } while (0)
        P1_LOAD(b0, xp);
#pragma unroll 1
        for (int gp = 0; gp < 4; ++gp) {
            P1_LOAD(b1, xp + 4 * DM);
            __builtin_amdgcn_sched_barrier(0); P1_PUT(b0, hp); __builtin_amdgcn_sched_barrier(0);
            if (gp < 3) P1_LOAD(b0, xp + 8 * DM);
            __builtin_amdgcn_sched_barrier(0); P1_PUT(b1, hp + 4 * DM); __builtin_amdgcn_sched_barrier(0);
            xp += 8 * DM; hp += 8 * DM;
        }
#undef P1_LOAD
#undef P1_PUT
    }
}

constexpr int PL_U = 0, PL_P = 36864, PL_W = 71680, PL_PITCH = 272;
__device__ __forceinline__ void pool_load_w(const bf16_t* wpool, int g, LAS unsigned char* lds, int tid) {
    const bf16_t* src = wpool + (size_t)g * 128 * 128;
    for (int i = tid; i < 128 * 16; i += 512) { const int d = i >> 4, ch = i & 15; *(LAS u32x4*)(lds + PL_W + d * PL_PITCH + ch * 16) = *(const u32x4*)(src + d * 128 + ch * 8); }
}
__device__ __forceinline__ void pool_unit(const bf16_t* proj, bf16_t* mixin, const float* pool_scale, int ht, int g, LAS unsigned char* lds, int tid, int wave, int lane) {
    const int t0 = ht * 128, s0 = t0 & (SEQ - 1), w = 2 << g;
    for (int i = tid; i < 143 * 16; i += 512) { const int j = i >> 4, ch = i & 15; const int s = s0 - 15 + j;
        u32x4 v = (u32x4){0u, 0u, 0u, 0u};
        if (s >= 0) v = *(const u32x4*)(proj + (size_t)(t0 - 15 + j) * IND + g * 128 + ch * 8);
        *(LAS u32x4*)(lds + PL_U + j * 256 + ch * 16) = v; }
    __syncthreads();
    {
        const int c = tid & 127, seg = tid >> 7, r0 = seg * 32;
        const LAS bf16_t* Uc = (const LAS bf16_t*)(lds + PL_U) + c;
        float sum = 0.f;
        for (int j = 1; j < w; ++j) sum += bf_lo((unsigned)Uc[(r0 + 15 - j) * 128]);
        for (int r = r0; r < r0 + 32; ++r) {
            const float cur = bf_lo((unsigned)Uc[(r + 15) * 128]);
            sum += cur;
            const int s = s0 + r; const float cnt = (float)((s + 1 < w) ? (s + 1) : w);
            const float pooled = sum / cnt - cur;
            *(LAS bf16_t*)(lds + PL_P + r * PL_PITCH + c * 2) = (bf16_t)(cvt_pk_bf16(pooled, 0.f) & 0xffffu);
            sum -= bf_lo((unsigned)Uc[(r + 15 - (w - 1)) * 128]);
        }
    }
    __syncthreads();
    {
        const int rb = wave & 3, dh = wave >> 2, r = lane & 31, hh = lane >> 5;
        f32x16 acc[2];
#pragma unroll
        for (int q = 0; q < 2; ++q)
#pragma unroll
            for (int i = 0; i < 16; ++i) acc[q][i] = 0.f;
#pragma unroll
        for (int s = 0; s < 8; ++s) {
            const bf16x8 pb = *(const LAS bf16x8*)(lds + PL_P + (rb * 32 + r) * PL_PITCH + (16 * s + 8 * hh) * 2);
#pragma unroll
            for (int q = 0; q < 2; ++q) { const bf16x8 wa = *(const LAS bf16x8*)(lds + PL_W + (dh * 64 + q * 32 + r) * PL_PITCH + (16 * s + 8 * hh) * 2);
                acc[q] = __builtin_amdgcn_mfma_f32_32x32x16_bf16(wa, pb, acc[q], 0, 0, 0); }
        }
        unsigned char* op = (unsigned char*)mixin + (size_t)(t0 + rb * 32 + r) * DM + g * 128 + dh * 64;
        const float* ps = pool_scale + g * 128 + dh * 64;
#pragma unroll
        for (int q = 0; q < 2; ++q)
#pragma unroll
            for (int a = 0; a < 4; ++a) { const int d = q * 32 + 8 * a + 4 * hh; const f32x4 sc = *(const f32x4*)(ps + d);
                *(unsigned*)(op + d) = pk4_fp8(acc[q][4 * a] * sc[0], acc[q][4 * a + 1] * sc[1], acc[q][4 * a + 2] * sc[2], acc[q][4 * a + 3] * sc[3]); }
    }
    __syncthreads();
}

constexpr int AT_K = 0, AT_V = 32768, AT_Q = 65536, AT_BT = MISC_OFF, AT_BT0 = 184;
typedef float f32x8v __attribute__((ext_vector_type(8)));
constexpr int AT_LAM = MISC_OFF + 1008;
constexpr float AT_THR = 8.f;
__device__ __forceinline__ float max3v(float a, float b, float c) { float r; asm volatile("v_max3_f32 %0, %1, %2, %3" : "=v"(r) : "v"(a), "v"(b), "v"(c)); return r; }
__device__ __forceinline__ void glds16s(const char* sbase, unsigned voff, unsigned lds_dst) {
    unsigned keep;
    asm volatile("s_mov_b32 %0, m0\n\ts_mov_b32 m0, %3\n\ts_nop 0\n\tglobal_load_lds_dwordx4 %1, %2\n\ts_mov_b32 m0, %0" : "=&s"(keep) : "v"(voff), "s"(sbase), "s"(lds_dst) : "memory");
}
__device__ __forceinline__ void attn_unit(const bf16_t* proj, bf16_t* mixin, const float* rel_table, const float* subln_g, float lam, int b, int h, int qb,
                                          LAS unsigned char* lds, int tid, int wave, int lane) {
    asm volatile("" : "+v"(lane), "+v"(tid));
    const int r = lane & 31, hh = lane >> 5;
    const int rowbase = b * SEQ, q0w = 256 * qb + 32 * wave, cw = 4 * qb + (wave >> 1), NT = 4 * qb + 4;
    if (tid < 248) { const int rel = tid - AT_BT0, n = rel < 0 ? -rel : rel; int v;
        if (n < 8) v = n; else v = 8 + (n >= 12) + (n >= 16) + (n >= 23) + (n >= 32) + (n >= 46) + (n >= 64) + (n >= 91);
        const int bucket = (rel > 0 ? 16 : 0) + v;
        ((LAS float*)(lds + AT_BT))[tid] = (rel_table[bucket * 4 + h] - rel_table[15 * 4 + h]) * LOG2E; }
    LAS unsigned char* Qw = lds + AT_Q + wave * 8192 + hh * 512 + r * 16;
    { const bf16_t* qp = proj + (size_t)(rowbase + q0w + r) * IND + 512 + h * 128 + hh * 8;
#pragma unroll
      for (int m = 0; m < 2; ++m)
#pragma unroll
          for (int s = 0; s < 4; ++s) *(LAS bf16x8*)(Qw + (m * 4 + s) * 1024) = *(const bf16x8*)(qp + m * 64 + s * 16); }
    const int vp0 = 2 * wave, vp1 = 2 * wave + 1;
    const char* kbase = (const char*)proj + ((size_t)(rowbase + 8 * wave) * IND + 1024 + h * 128) * 2;
    const char* vbase0 = (const char*)proj + ((size_t)(rowbase + 16 * (vp0 & 3)) * IND + 1536 + h * 128 + 32 * (vp0 >> 2)) * 2;
    const char* vbase1 = (const char*)proj + ((size_t)(rowbase + 16 * (vp1 & 3)) * IND + 1536 + h * 128 + 32 * (vp1 >> 2)) * 2;
    const unsigned lds0 = (unsigned)(uintptr_t)lds;
#define AT_DMA_K(t, buf) do { int ln_ = lane; asm volatile("" : "+v"(ln_)); \
        const unsigned lk_ = (unsigned)(ln_ >> 4) * (IND * 2) + (unsigned)(((ln_ & 15) ^ ((8 * wave + (ln_ >> 4)) & 15)) * 16), lk2_ = (unsigned)(4 + (ln_ >> 4)) * (IND * 2) + (unsigned)(((ln_ & 15) ^ ((8 * wave + 4 + (ln_ >> 4)) & 15)) * 16); \
        const char* _b = kbase + (size_t)(t) * 64 * IND * 2; const unsigned _d = (unsigned)__builtin_amdgcn_readfirstlane((int)(lds0 + AT_K + (buf) * 16384 + (2 * wave) * 1024)); \
        glds16s(_b, lk_, _d); glds16s(_b, lk2_, _d + 1024u); } while (0)
#define AT_DMA_V(t, buf) do { int ln_ = lane; asm volatile("" : "+v"(ln_)); const unsigned lv_ = (unsigned)(ln_ >> 2) * (IND * 2) + (unsigned)(ln_ & 3) * 16u; \
        const size_t _o = (size_t)(t) * 64 * IND * 2; const unsigned _d = (unsigned)__builtin_amdgcn_readfirstlane((int)(lds0 + AT_V + (buf) * 16384)); \
        glds16s(vbase0 + _o, lv_, _d + (unsigned)(vp0 * 1024)); glds16s(vbase1 + _o, lv_, _d + (unsigned)(vp1 * 1024)); } while (0)
    f32x16 O[2][4];
#pragma unroll
    for (int m = 0; m < 2; ++m)
#pragma unroll
        for (int d = 0; d < 4; ++d)
#pragma unroll
            for (int i = 0; i < 16; ++i) O[m][d][i] = 0.f;
    float mrun[2] = {0.f, 0.f}, lrun[2] = {0.f, 0.f};
    const int kfo = r * 256 + (((r & 15) ^ hh) << 4);
    const int vfo = ((lane >> 4) & 1) * 32 + (lane & 3) * 8 + (4 * hh + ((lane & 15) >> 2)) * 64;
    f32x16 sA, sB; bf16x8 pf[4];
#pragma unroll
    for (int i = 0; i < 16; ++i) { sA[i] = 0.f; sB[i] = 0.f; }
#pragma unroll
    for (int k = 0; k < 4; ++k) pf[k] = (bf16x8){0, 0, 0, 0, 0, 0, 0, 0};
#define AT_VLD(dst, Vb, ks) do { _Pragma("unroll") for (int d_ = 0; d_ < 4; ++d_) { const LAS unsigned char* vp_ = (Vb) + (d_ * 4 + (ks)) * 1024 + vfo; \
            const s16x4 lo_ = __builtin_bit_cast(s16x4, __builtin_amdgcn_ds_read_tr16_b64_v4i16((LAS s16x4*)vp_)); \
            const s16x4 hi_ = __builtin_bit_cast(s16x4, __builtin_amdgcn_ds_read_tr16_b64_v4i16((LAS s16x4*)(vp_ + 512))); \
            dst[d_] = (bf16x8){lo_[0], lo_[1], lo_[2], lo_[3], hi_[0], hi_[1], hi_[2], hi_[3]}; } } while (0)
#define AT_KLD(ka_, kb_, qf_, Kb, m, s) do { const int ko_ = kfo ^ (((m) * 8 + 2 * (s)) << 4); ka_ = *(const LAS bf16x8*)((Kb) + ko_); kb_ = *(const LAS bf16x8*)((Kb) + ko_ + 8192); \
        qf_ = *(const LAS bf16x8*)(Qw + ((m) * 4 + (s)) * 1024); } while (0)
#define AT_S(m, t) do { const LAS unsigned char* Kb = lds + AT_K + ((t) & 1) * 16384; \
        bf16x8 ka_[3], kb_[3], qf_[3]; \
        AT_KLD(ka_[0], kb_[0], qf_[0], Kb, m, 0); AT_KLD(ka_[1], kb_[1], qf_[1], Kb, m, 1); \
        { const float nm_ = -mrun[m]; _Pragma("unroll") for (int i = 0; i < 16; ++i) { sA[i] = nm_; sB[i] = nm_; } } \
        _Pragma("unroll") for (int s = 0; s < 4; ++s) { \
            if (s < 2) AT_KLD(ka_[(s + 2) % 3], kb_[(s + 2) % 3], qf_[(s + 2) % 3], Kb, m, s + 2); \
            __builtin_amdgcn_sched_barrier(0); \
            sA = __builtin_amdgcn_mfma_f32_32x32x16_bf16(ka_[s % 3], qf_[s % 3], sA, 0, 0, 0); sB = __builtin_amdgcn_mfma_f32_32x32x16_bf16(kb_[s % 3], qf_[s % 3], sB, 0, 0, 0); \
            __builtin_amdgcn_sched_barrier(0); } } while (0)
#define AT_PV(m, t) do { const LAS unsigned char* Vb = lds + AT_V + ((t) & 1) * 16384; \
        bf16x8 vf_[3][4]; \
        AT_VLD(vf_[0], Vb, 0); AT_VLD(vf_[1], Vb, 1); \
        _Pragma("unroll") for (int ks = 0; ks < 4; ++ks) { \
            if (ks < 2) AT_VLD(vf_[(ks + 2) % 3], Vb, ks + 2); \
            __builtin_amdgcn_sched_barrier(0); \
            _Pragma("unroll") for (int d = 0; d < 4; ++d) O[m][d] = __builtin_amdgcn_mfma_f32_32x32x16_bf16(vf_[ks % 3][d], pf[ks], O[m][d], 0, 0, 0); \
            __builtin_amdgcn_sched_barrier(0); } } while (0)
#define AT_SM(m, t) do { \
        if ((64 * (t) + 63 - q0w) > -91) { const LAS float* bp = (const LAS float*)(lds + AT_BT) + (64 * (t) - q0w - r + AT_BT0 + 4 * hh); \
            _Pragma("unroll") for (int a = 0; a < 4; ++a) _Pragma("unroll") for (int j = 0; j < 4; ++j) { sA[4 * a + j] += bp[8 * a + j]; sB[4 * a + j] += bp[32 + 8 * a + j]; } } \
          \
        float c0_ = __builtin_fmaxf(__builtin_fmaxf(sA[0], sA[1]), sA[2]), c1_ = __builtin_fmaxf(__builtin_fmaxf(sA[8], sA[9]), sA[10]), c2_ = __builtin_fmaxf(__builtin_fmaxf(sB[0], sB[1]), sB[2]), c3_ = __builtin_fmaxf(__builtin_fmaxf(sB[8], sB[9]), sB[10]); \
        c0_ = __builtin_fmaxf(__builtin_fmaxf(c0_, sA[3]), sA[4]); c1_ = __builtin_fmaxf(__builtin_fmaxf(c1_, sA[11]), sA[12]); c2_ = __builtin_fmaxf(__builtin_fmaxf(c2_, sB[3]), sB[4]); c3_ = __builtin_fmaxf(__builtin_fmaxf(c3_, sB[11]), sB[12]); \
        c0_ = __builtin_fmaxf(__builtin_fmaxf(c0_, sA[5]), sA[6]); c1_ = __builtin_fmaxf(__builtin_fmaxf(c1_, sA[13]), sA[14]); c2_ = __builtin_fmaxf(__builtin_fmaxf(c2_, sB[5]), sB[6]); c3_ = __builtin_fmaxf(__builtin_fmaxf(c3_, sB[13]), sB[14]); \
        c0_ = __builtin_fmaxf(__builtin_fmaxf(c0_, sA[7]), c1_); c2_ = __builtin_fmaxf(__builtin_fmaxf(c2_, sB[7]), c3_); \
        float tmax = __builtin_fmaxf(__builtin_fmaxf(c0_, sA[15]), __builtin_fmaxf(c2_, sB[15])); \
        { const auto r_ = __builtin_amdgcn_permlane32_swap(__float_as_uint(tmax), __float_as_uint(tmax), false, false); tmax = __builtin_fmaxf(__uint_as_float(r_[0]), __uint_as_float(r_[1])); }     \
        if ((t) == 0 || __any(tmax > AT_THR)) {          \
            const float dl = ((t) == 0) ? tmax : fmaxf(tmax, 0.f); \
            if ((t) != 0) { const float al = __builtin_amdgcn_exp2f(-dl); lrun[m] *= al; \
                _Pragma("unroll") for (int d = 0; d < 4; ++d) _Pragma("unroll") for (int i = 0; i < 16; ++i) O[m][d][i] *= al; } \
            mrun[m] += dl; \
            _Pragma("unroll") for (int i = 0; i < 16; ++i) { sA[i] -= dl; sB[i] -= dl; } } \
        _Pragma("unroll") for (int i = 0; i < 16; ++i) { sA[i] = __builtin_amdgcn_exp2f(sA[i]); sB[i] = __builtin_amdgcn_exp2f(sB[i]); } \
        { const f32x16 s16_ = sA + sB; const f32x8v s8_ = s16_.lo + s16_.hi; const f32x4 s4_ = s8_.lo + s8_.hi; const f32x2 s2_ = s4_.lo + s4_.hi; lrun[m] += s2_.x + s2_.y; }     \
        _Pragma("unroll") for (int s2 = 0; s2 < 2; ++s2) { u32x4 pa, pb; \
            pa.x = cvt_pk_bf16(sA[8 * s2 + 0], sA[8 * s2 + 1]); pa.y = cvt_pk_bf16(sA[8 * s2 + 2], sA[8 * s2 + 3]); pa.z = cvt_pk_bf16(sA[8 * s2 + 4], sA[8 * s2 + 5]); pa.w = cvt_pk_bf16(sA[8 * s2 + 6], sA[8 * s2 + 7]); \
            pb.x = cvt_pk_bf16(sB[8 * s2 + 0], sB[8 * s2 + 1]); pb.y = cvt_pk_bf16(sB[8 * s2 + 2], sB[8 * s2 + 3]); pb.z = cvt_pk_bf16(sB[8 * s2 + 4], sB[8 * s2 + 5]); pb.w = cvt_pk_bf16(sB[8 * s2 + 6], sB[8 * s2 + 7]); \
            pf[s2] = __builtin_bit_cast(bf16x8, pa); pf[2 + s2] = __builtin_bit_cast(bf16x8, pb); } } while (0)
    const int grp = wave >> 2;
    AT_DMA_K(0, 0); AT_DMA_V(0, 0);
#define AT_SYNC(tb, ph) do { \
        if ((ph) == 0) { if ((tb) < NT) asm volatile("s_waitcnt vmcnt(2)" ::: "memory"); else asm volatile("s_waitcnt vmcnt(0)" ::: "memory"); } \
        else if ((ph) == 2) { if ((tb) + 1 < NT) asm volatile("s_waitcnt vmcnt(2)" ::: "memory"); else asm volatile("s_waitcnt vmcnt(0)" ::: "memory"); } \
        asm volatile("s_waitcnt lgkmcnt(0)" ::: "memory"); __builtin_amdgcn_s_barrier(); asm volatile("" ::: "memory"); \
        if ((ph) == 0) { if ((tb) + 1 < NT) AT_DMA_K((tb) + 1, ((tb) + 1) & 1); } \
        else if ((ph) == 2) { if ((tb) + 1 < NT) AT_DMA_V((tb) + 1, ((tb) + 1) & 1); } } while (0)
    if (grp == 0) {
#pragma unroll 1
        for (int t = 0; t < NT; ++t) {
            AT_SYNC(t, 0); if (t >= 1 && t - 1 <= cw) AT_PV(1, t - 1); if (t <= cw) AT_S(0, t);
            AT_SYNC(t, 1); if (t <= cw) AT_SM(0, t);
            AT_SYNC(t, 2); if (t <= cw) { AT_PV(0, t); AT_S(1, t); }
            AT_SYNC(t, 3); if (t <= cw) AT_SM(1, t);
        }
        AT_SYNC(NT, 0); if (NT - 1 <= cw) AT_PV(1, NT - 1);
        AT_SYNC(NT, 1);
    } else {
#pragma unroll 1
        for (int t = 0; t < NT; ++t) {
            AT_SYNC(t, 0); if (t >= 1 && t - 1 <= cw) AT_SM(1, t - 1);
            AT_SYNC(t, 1); if (t >= 1 && t - 1 <= cw) AT_PV(1, t - 1); if (t <= cw) AT_S(0, t);
            AT_SYNC(t, 2); if (t <= cw) AT_SM(0, t);
            AT_SYNC(t, 3); if (t <= cw) { AT_PV(0, t); AT_S(1, t); }
        }
        AT_SYNC(NT, 0); if (NT - 1 <= cw) AT_SM(1, NT - 1);
        AT_SYNC(NT, 1); if (NT - 1 <= cw) AT_PV(1, NT - 1);
    }
#undef AT_SYNC
#undef AT_S
#undef AT_VLD
#undef AT_KLD
#undef AT_PV
#undef AT_SM
#undef AT_DMA_K
#undef AT_DMA_V
    const float l0 = lrun[0] + __shfl_xor(lrun[0], 32), l1 = lrun[1] + __shfl_xor(lrun[1], 32);
    const float lam_v = *(const LAS float*)(lds + AT_LAM);
    const float i0 = 1.f / l0, i1 = lam_v / l1;
    float ss = 0.f;
#pragma unroll
    for (int d = 0; d < 4; ++d)
#pragma unroll
        for (int i = 0; i < 16; ++i) { const float o = O[0][d][i] * i0 - O[1][d][i] * i1; O[0][d][i] = o; ss += o * o; }
    ss += __shfl_xor(ss, 32);
    const float rs = (1.f - LAMBDA_INIT) / sqrtf(ss * (1.f / 128.f) + LN_EPS);
    unsigned char* op = (unsigned char*)mixin + (size_t)(rowbase + q0w + r) * DM + 512 + h * 128;
#pragma unroll
    for (int d = 0; d < 4; ++d)
#pragma unroll
        for (int a = 0; a < 4; ++a) { const int dd = 32 * d + 8 * a + 4 * hh; const f32x4 g = *(const f32x4*)(subln_g + dd);
            *(unsigned*)(op + dd) = pk4_fp8(O[0][d][4 * a] * rs * g[0], O[0][d][4 * a + 1] * rs * g[1], O[0][d][4 * a + 2] * rs * g[2], O[0][d][4 * a + 3] * rs * g[3]); }
    __syncthreads();
}

__device__ __forceinline__ void p5_ln1(const float* x, const bf16_t* mix, const float* modf, const float* ln_g, const float* ln_b, bf16_t* x1s, bf16_t* h2, unsigned char* h2f8, int pm, int wave, int lane) {
    const int row0 = pm * 256 + wave * 32, b = row0 >> 11;
    const float* mb = modf + (size_t)b * 6144;
    float g1[16], lg[16], lb[16], s2[16], t2[16];
#pragma unroll
    for (int w = 0; w < 4; ++w) { const int col = 256 * w + 4 * lane;
        const f32x4 a = *(const f32x4*)(mb + 2048 + col), bq = *(const f32x4*)(ln_g + col), c = *(const f32x4*)(ln_b + col), d = *(const f32x4*)(mb + 3072 + col), e = *(const f32x4*)(mb + 4096 + col);
#pragma unroll
        for (int q = 0; q < 4; ++q) { g1[w * 4 + q] = a[q]; lg[w * 4 + q] = bq[q]; lb[w * 4 + q] = c[q]; t2[w * 4 + q] = d[q]; s2[w * 4 + q] = 1.f + e[q]; } }
#pragma unroll 1
    for (int r2 = 0; r2 < 32; r2 += 2) {
        f32x4 xa[2][4]; u32x2 mm[2][4];
#pragma unroll
        for (int q = 0; q < 2; ++q) { const size_t ro = (size_t)(row0 + r2 + q) * DM + 4 * lane;
#pragma unroll
            for (int w = 0; w < 4; ++w) { xa[q][w] = *(const f32x4*)(x + ro + 256 * w); mm[q][w] = *(const u32x2*)(mix + ro + 256 * w); } }
#pragma unroll
        for (int q = 0; q < 2; ++q) {
            const size_t ro = (size_t)(row0 + r2 + q) * DM + 4 * lane;
            float v[16];
#pragma unroll
            for (int w = 0; w < 4; ++w) { const f32x4 a = xa[q][w]; const u32x2 m = mm[q][w];
                v[w * 4 + 0] = ALPHA * a[0] + g1[w * 4 + 0] * bf_lo(m.x); v[w * 4 + 1] = ALPHA * a[1] + g1[w * 4 + 1] * bf_hi(m.x);
                v[w * 4 + 2] = ALPHA * a[2] + g1[w * 4 + 2] * bf_lo(m.y); v[w * 4 + 3] = ALPHA * a[3] + g1[w * 4 + 3] * bf_hi(m.y); }
            float s = 0.f;
#pragma unroll
            for (int k = 0; k < 16; ++k) s += v[k];
            const float mean = wave_sum(s) * (1.f / DM);
            float q2 = 0.f;
#pragma unroll
            for (int k = 0; k < 16; ++k) { v[k] -= mean; q2 += v[k] * v[k]; }
            const float rstd = 1.f / sqrtf(wave_sum(q2) * (1.f / DM) + LN_EPS);
            float x1[16], hv[16];
#pragma unroll
            for (int k = 0; k < 16; ++k) { x1[k] = v[k] * rstd * lg[k] + lb[k]; hv[k] = x1[k] * s2[k] + t2[k]; }
#pragma unroll
            for (int w = 0; w < 4; ++w) { u32x2 w1, w2;
                w1.x = cvt_pk_bf16(ALPHA * x1[w * 4 + 0], ALPHA * x1[w * 4 + 1]); w1.y = cvt_pk_bf16(ALPHA * x1[w * 4 + 2], ALPHA * x1[w * 4 + 3]);
                w2.x = cvt_pk_bf16(hv[w * 4 + 0], hv[w * 4 + 1]); w2.y = cvt_pk_bf16(hv[w * 4 + 2], hv[w * 4 + 3]);
                *(u32x2*)(x1s + ro + 256 * w) = w1; *(u32x2*)(h2 + ro + 256 * w) = w2;
                *(unsigned*)(h2f8 + ro + 256 * w) = pk4_fp8(hv[w * 4 + 0], hv[w * 4 + 1], hv[w * 4 + 2], hv[w * 4 + 3]); }
        }
    }
}
typedef unsigned long long u64_t;
__device__ __forceinline__ float sigm_fast(float x) { return __builtin_amdgcn_rcpf(1.f + __builtin_amdgcn_exp2f(-LOG2E * x)); }
__device__ __forceinline__ u64_t rkey(float s, int e) { const unsigned u = __builtin_bit_cast(unsigned, s); const unsigned o = u ^ ((u >> 31) ? 0xFFFFFFFFu : 0x80000000u); return ((u64_t)o << 32) | (unsigned)(~e); }
__device__ __forceinline__ float rkey_score(u64_t k) { const unsigned o = (unsigned)(k >> 32); const unsigned u = (o & 0x80000000u) ? (o ^ 0x80000000u) : ~o; return __builtin_bit_cast(float, u); }
#define TOP8_INSERT(key) do { const u64_t k__ = (key); if (k__ > tk[7]) { tk[7] = k__; \
        _Pragma("unroll") for (int p_ = 7; p_ > 0; --p_) { const u64_t hi_ = tk[p_] > tk[p_ - 1] ? tk[p_] : tk[p_ - 1], lo_ = tk[p_] > tk[p_ - 1] ? tk[p_ - 1] : tk[p_]; tk[p_ - 1] = hi_; tk[p_] = lo_; } } } while (0)
__device__ __forceinline__ void p5_route_quad(const float* logits, LAS float* L, const LAS float* rb, LAS unsigned* hist, int* ae, float* aw, int* ar, int tid, int tok) {
    const int q = tid & 3;
    LAS float* mine = L + tid * 65;
    const LAS float* rbq = rb + 64 * q;
    float gsum[2], gm2[2];
    { const f32x4* src = (const f32x4*)(logits + (size_t)tok * NEXP + 64 * q);
      f32x4 v[16];
#pragma unroll
      for (int i = 0; i < 16; ++i) v[i] = src[i];
#pragma unroll
      for (int gg = 0; gg < 2; ++gg) { float m1 = -1e30f, m2 = -1e30f;
#pragma unroll
          for (int j = 0; j < 32; ++j) { const int jj = gg * 32 + j; const float s = sigm_fast(v[jj >> 2][jj & 3]) + rbq[jj]; mine[jj] = s;
              if (s > m1) { m2 = m1; m1 = s; } else if (s > m2) m2 = s; }
          gsum[gg] = m1 + m2; gm2[gg] = m2; } }
    float gs[8];
    { const float a0 = __shfl_xor(gsum[0], 1), a1 = __shfl_xor(gsum[1], 1);
      float p0 = (q & 1) ? a0 : gsum[0], p1 = (q & 1) ? a1 : gsum[1], p2 = (q & 1) ? gsum[0] : a0, p3 = (q & 1) ? gsum[1] : a1;
      const float b0 = __shfl_xor(p0, 2), b1 = __shfl_xor(p1, 2), b2 = __shfl_xor(p2, 2), b3 = __shfl_xor(p3, 2);
      const bool hi = (q & 2) != 0;
      gs[0] = hi ? b0 : p0; gs[1] = hi ? b1 : p1; gs[2] = hi ? b2 : p2; gs[3] = hi ? b3 : p3;
      gs[4] = hi ? p0 : b0; gs[5] = hi ? p1 : b1; gs[6] = hi ? p2 : b2; gs[7] = hi ? p3 : b3; }
    unsigned selmask = 0u;
#pragma unroll
    for (int g = 0; g < 8; ++g) { int rank = 0;
#pragma unroll
        for (int o = 0; o < 8; ++o) rank += (gs[o] > gs[g] || (gs[o] == gs[g] && o < g)) ? 1 : 0;
        if (rank < 4) selmask |= 1u << g; }
    const bool sel0 = (selmask >> (2 * q)) & 1u, sel1 = (selmask >> (2 * q + 1)) & 1u;
    float tau = fminf(sel0 ? gm2[0] : 3e38f, sel1 ? gm2[1] : 3e38f);
    tau = fminf(tau, __shfl_xor(tau, 1)); tau = fminf(tau, __shfl_xor(tau, 2));
    u64_t cand = 0ull;
#pragma unroll 8
    for (int j = 0; j < 64; ++j) { const bool ok = (mine[j] >= tau) && ((j < 32) ? sel0 : sel1); cand |= ok ? (1ull << j) : 0ull; }
    u64_t tk[8];
#pragma unroll
    for (int k = 0; k < 8; ++k) tk[k] = 0ull;
    while (__any(cand != 0ull)) {
        if (cand != 0ull) { const int j = __builtin_ctzll(cand); cand &= cand - 1ull; TOP8_INSERT(rkey(mine[j], 64 * q + j)); }
    }
#pragma unroll
    for (int rnd = 1; rnd <= 2; ++rnd) {
        u64_t ok[8];
#pragma unroll
        for (int k = 0; k < 8; ++k) { const unsigned lo = __shfl_xor((unsigned)tk[k], rnd), hi = __shfl_xor((unsigned)(tk[k] >> 32), rnd); ok[k] = ((u64_t)hi << 32) | lo; }
#pragma unroll
        for (int k = 0; k < 8; ++k) TOP8_INSERT(ok[k]);
    }
    float wv[8]; int ei[8]; float wsum = 0.f;
#pragma unroll
    for (int k = 0; k < 8; ++k) { ei[k] = (int)(~(unsigned)tk[k]) & 255; wv[k] = rkey_score(tk[k]) - rb[ei[k]]; wsum += wv[k]; }
    const float inv = 2.5f / wsum;
#pragma unroll
    for (int k = 0; k < 8; ++k) if ((k >> 1) == q) { const unsigned rk = __hip_atomic_fetch_add(hist + ei[k], 1u, __ATOMIC_RELAXED, __HIP_MEMORY_SCOPE_WORKGROUP);
        ae[(size_t)tok * 8 + k] = ei[k]; aw[(size_t)tok * 8 + k] = wv[k] * inv; ar[(size_t)tok * 8 + k] = (int)rk; }
}
__device__ __forceinline__ void p6_phase(unsigned char* ws, LAS unsigned char* misc, int wg, int G, int tid) {
    const int* cnt = (const int*)(ws + WS_CNT); const int* ae = (const int*)(ws + WS_AE); const float* aw = (const float*)(ws + WS_AW); int* ar = (int*)(ws + WS_AR);
    int* stok = (int*)(ws + WS_STOK); int* sdst = (int*)(ws + WS_SDST); float* sw = (float*)(ws + WS_SW); int* tile_e = (int*)(ws + WS_TILE_E);
    LAS int* tot = (LAS int*)misc; LAS int* part = (LAS int*)(misc + 1024); LAS int* start = (LAS int*)(misc + 2048);
    const int npan = NTOK / 256;
    {
        const int e = tid & (NEXP - 1), hf = tid >> 8, w0 = hf * (npan / 2);
        int t = 0, p = 0;
#pragma unroll 16
        for (int w = w0; w < w0 + npan / 2; ++w) { const int c = cnt[w * NEXP + e]; t += c; p += (w < wg) ? c : 0; }
        LAS int* tmp = (LAS int*)(misc + 8192);
        if (hf) { tmp[e] = t; tmp[NEXP + e] = p; }
        __syncthreads();
        if (!hf) { tot[e] = t + tmp[e]; part[e] = p + tmp[NEXP + e]; }
    }
    __syncthreads();
    if (tid < 64) {
        int pd[4], s = 0;
#pragma unroll
        for (int j = 0; j < 4; ++j) { pd[j] = (tot[4 * tid + j] + 255) & ~255; s += pd[j]; }
        int incl = s;
#pragma unroll
        for (int o = 1; o < 64; o <<= 1) { const int v = __shfl_up(incl, o); if (tid >= o) incl += v; }
        int acc = incl - s;
#pragma unroll
        for (int j = 0; j < 4; ++j) { start[4 * tid + j] = acc; acc += pd[j]; }
        if (tid == 63 && wg == 0) tile_e[4096] = incl >> 8;
    }
    __syncthreads();
    for (int pan = wg; pan < npan; pan += G) {
        if (pan != wg) { __syncthreads(); if (tid < NEXP) { int p = 0; for (int w = 0; w < pan; ++w) p += cnt[w * NEXP + tid]; part[tid] = p; } __syncthreads(); }
        for (int i = tid; i < 256 * 8; i += 512) { const size_t a = (size_t)pan * 2048 + i; const int e = ae[a]; const int slot = start[e] + part[e] + ar[a];
            stok[slot] = (int)(a >> 3); sdst[slot] = (int)a; sw[slot] = aw[a]; ar[a] = slot; }
    }
    for (int e = wg; e < NEXP; e += G) { const int t = tot[e], pad = ((t + 255) & ~255) - t, s0 = start[e] + t;
        for (int i = tid; i < pad; i += 512) { stok[s0 + i] = 0; sdst[s0 + i] = -1; sw[s0 + i] = 0.f; }
        const int nt = (t + 255) >> 8, t0 = start[e] >> 8;
        for (int i = tid; i < nt; i += 512) tile_e[t0 + i] = e; }
}
__device__ __forceinline__ void p9_phase(const unsigned char* Y, const int* slotof, const bf16_t* x1s, const float* modf, const float* ln_g, const float* ln_b, float* out, int gw, int NGW, int lane) {
    for (int blk = gw; blk < NTOK / 32; blk += NGW) {
        const int row0 = blk * 32, b = row0 >> 11;
        float g2[16], lg[16], lb[16];
#pragma unroll
        for (int k = 0; k < 16; ++k) { g2[k] = modf[(size_t)b * 6144 + 5120 + 16 * lane + k] * YINV; lg[k] = ln_g[16 * lane + k]; lb[k] = ln_b[16 * lane + k]; }
#pragma unroll 2
        for (int rr = 0; rr < 32; ++rr) {
            const int row = row0 + rr;
            float f[16];
#pragma unroll
            for (int k = 0; k < 16; ++k) f[k] = 0.f;
            int sl[8];
#pragma unroll
            for (int s = 0; s < 8; ++s) sl[s] = __builtin_amdgcn_readfirstlane(slotof[(size_t)row * 8 + s]);
#pragma unroll
            for (int s = 0; s < 8; ++s) { const u32x4 pk = __builtin_nontemporal_load((const u32x4*)(Y + (size_t)sl[s] * 1024 + 16 * lane));
#pragma unroll
                for (int w = 0; w < 4; ++w) { const f32x2 lo = __builtin_amdgcn_cvt_pk_f32_fp8((int)pk[w], false), hi = __builtin_amdgcn_cvt_pk_f32_fp8((int)pk[w], true);
                    f[4 * w + 0] += lo[0]; f[4 * w + 1] += lo[1]; f[4 * w + 2] += hi[0]; f[4 * w + 3] += hi[1]; } }
            const u32x4 xa = *(const u32x4*)(x1s + (size_t)row * DM + 16 * lane), xb = *(const u32x4*)(x1s + (size_t)row * DM + 16 * lane + 8);
            float v[16];
#pragma unroll
            for (int w = 0; w < 4; ++w) { v[2 * w] = bf_lo(xa[w]) + g2[2 * w] * f[2 * w]; v[2 * w + 1] = bf_hi(xa[w]) + g2[2 * w + 1] * f[2 * w + 1];
                v[8 + 2 * w] = bf_lo(xb[w]) + g2[8 + 2 * w] * f[8 + 2 * w]; v[8 + 2 * w + 1] = bf_hi(xb[w]) + g2[8 + 2 * w + 1] * f[8 + 2 * w + 1]; }
            float s = 0.f;
#pragma unroll
            for (int k = 0; k < 16; ++k) s += v[k];
            const float mean = wave_sum(s) * (1.f / DM);
            float q2 = 0.f;
#pragma unroll
            for (int k = 0; k < 16; ++k) { v[k] -= mean; q2 += v[k] * v[k]; }
            const float rstd = 1.f / sqrtf(wave_sum(q2) * (1.f / DM) + LN_EPS);
            float* orow = out + (size_t)row * DM + 16 * lane;
#pragma unroll
            for (int w = 0; w < 4; ++w) *(f32x4*)(orow + 4 * w) = (f32x4){v[4 * w] * rstd * lg[4 * w] + lb[4 * w], v[4 * w + 1] * rstd * lg[4 * w + 1] + lb[4 * w + 1], v[4 * w + 2] * rstd * lg[4 * w + 2] + lb[4 * w + 2], v[4 * w + 3] * rstd * lg[4 * w + 3] + lb[4 * w + 3]};
        }
    }
}

#ifndef MK_N_LAUNCHES
#define MK_N_LAUNCHES 1
#endif
constexpr int N_PHASES = 10;
constexpr int CV_SPLIT = (P0_N_EXP / 3) / 2048 * 2048;
struct Args { const float* in[26]; float* out; unsigned char* ws; int ph_lo, ph_hi; };
__global__ void __launch_bounds__(NWAVES * 64, 2) mega_fwd(Args args) {
    extern __shared__ __attribute__((aligned(16))) unsigned char lds_raw[];
    LAS unsigned char* lds = (LAS unsigned char*)lds_raw;
    LAS unsigned char* misc = lds + MISC_OFF;
    const int tid_arg = threadIdx.x, wave = __builtin_amdgcn_readfirstlane(tid_arg >> 6);
    const int G = gridDim.x, bx = blockIdx.x, vcu = (G % 8 == 0) ? (bx % 8) * (G / 8) + bx / 8 : bx;
    const int gw = vcu * NWAVES + wave, NGW = G * NWAVES;
    unsigned char* ws_arg = args.ws;
    const int lo = args.ph_lo, hi = args.ph_hi;
    volatile LAS unsigned* xbw = (volatile LAS unsigned*)(misc + 4032);
    if (tid_arg < 4) xbw[tid_arg] = 0u;
    __syncthreads();
    XcdBarrier bar; bar.bar = (unsigned*)(ws_arg + WS_CTL) + CW_BAR; bar.x = 0; bar.st = xbw;
    if (hi - lo > 1) bar = xcd_barrier_post((unsigned*)(ws_arg + WS_CTL) + CW_BAR, xbw);
#define IN(k) (lo <= (k) && (k) < hi)
#define SEAM(k) do { if (IN(k) && IN((k) + 1)) xcd_barrier(bar); } while (0)
#define CAS __attribute__((address_space(4)))
#define GP(T, p) ((T*)(GAS T*)(p))
#define KARGS() const CAS Args* ka = (const CAS Args*)__builtin_amdgcn_kernarg_segment_ptr(); asm volatile("" : "+s"(ka)); unsigned char* ws = GP(unsigned char, ka->ws); float* outp = GP(float, ka->out); (void)outp
#define AIN(k) GP(const float, ka->in[k])
#define LAUNDER() KARGS(); int tid = tid_arg; asm volatile("" : "+v"(tid)); const int lane = tid & 63

    if (IN(0)) { LAUNDER();
        P0Ptrs P; P.c = AIN(1); P.w_ada = AIN(2); P.w_in = AIN(4); P.w_out = AIN(12); P.w_router = AIN(15); P.ws_gate = AIN(20); P.ws_up = AIN(21); P.ws_down = AIN(22);
        P.pool_w = AIN(5); P.w_gate = AIN(17); P.w_up = AIN(18); P.w_down = AIN(19); P.ws = ws;
        p0_phase(P, lds, gw, NGW, wave, lane);
    }
    SEAM(0);
    if (IN(1)) { LAUNDER(); p1_phase(AIN(0), AIN(3), ws, gw, NGW, lane, bx * (NWAVES * 64) + tid, G * NWAVES * 64); }
    SEAM(1);
    if (IN(2)) { LAUNDER();
        const int grp4 = vcu & 3, k0 = (grp4 == 0) ? 0 : (grp4 == 1) ? 3 : (grp4 == 2) ? 5 : 8;
        const int nrounds = (NTOK / 256) * (IND / 256) / G;
        DenseOrder S; S.init(ws + WS_BUFA, ws + WS_WIN, NTOK, IND, DM / 2, G, bx); S.gmode = 1;
        EpiDenseBf16 E{(bf16_t*)outp, IND, 2, 4, QSCALE, 1.f / WSCALE};
        if (k0 > 0) { S.ioff = 0; S.imax = k0; pg8::gemm_phase<EpiDenseBf16, DenseOrder, true, true, true>(lds, DM / 2, S, E); __syncthreads(); }
        p0_expert_stream(AIN(17), AIN(18), AIN(19), ws, lds, gw, NGW, wave, lane, 0, CV_SPLIT); VM_WAIT(); __syncthreads();
        if (k0 < nrounds + 1) { S.ioff = k0; S.imax = 1 << 30; pg8::gemm_phase<EpiDenseBf16, DenseOrder, true, true, true>(lds, DM / 2, S, E); }
    }
    SEAM(2);
    if (IN(3)) { LAUNDER();
        const bf16_t* proj = (const bf16_t*)outp; bf16_t* mixin = (bf16_t*)(ws + WS_BUFA);
        int gl = -1;
        for (int u = vcu; u < 2048; u += G) { const int g = u & 3, ht = u >> 2;
            if (g != gl) { __syncthreads(); pool_load_w((const bf16_t*)(ws + WS_WPOOL), g, lds, tid); gl = g; }
            pool_unit(proj, mixin, AIN(6), ht, g, lds, tid, wave, lane); }
        __syncthreads();
        const float s1 = wave_sum(AIN(7)[lane] * AIN(8)[lane]), s2 = wave_sum(AIN(9)[lane] * AIN(10)[lane]);
        { const float lam0 = __expf(s1) - __expf(s2) + LAMBDA_INIT; if (tid == 0) *(LAS float*)(lds + AT_LAM) = lam0; }
        const float lam = 0.f;
        const int nun = (G == 256) ? 4 : (1024 - vcu + G - 1) / G;
#pragma unroll 1
        for (int i = 0; i <= nun; ++i) {
            if (i == ((vcu & 3) * nun) / 3) {
                int ln_ = lane; asm volatile("" : "+v"(ln_));
                p0_expert_stream(AIN(17), AIN(18), AIN(19), ws, lds, gw, NGW, wave, ln_, CV_SPLIT, P0_N_EXP); VM_WAIT(); __syncthreads(); }
            if (i == nun) break;
            int bh, qb;
            if (G == 256) { const int p = vcu & 1; bh = vcu >> 1; qb = p ? ((i == 0) ? 6 : (i == 1) ? 1 : (i == 2) ? 5 : 2) : ((i == 0) ? 7 : (i == 1) ? 0 : (i == 2) ? 4 : 3); }
            else { const int u = vcu + i * G; bh = u >> 3; qb = u & 7; }
            attn_unit(proj, mixin, AIN(25), AIN(11), lam, bh >> 2, bh & 3, qb, lds, tid, wave, lane);
        }
    }
    SEAM(3);
    if (IN(4)) { LAUNDER(); (void)lane;
        DenseOrder S; S.init(ws + WS_BUFA, ws + WS_WOUT, NTOK, DM, DM / 2, G, bx); S.gmode = 1;
        EpiDenseBf16 E{(bf16_t*)(ws + WS_BUFB), DM, 0, 0, 1.f, 1.f / WSCALE};
        pg8::gemm_phase<EpiDenseBf16, DenseOrder, true, true, true>(lds, DM / 2, S, E);
    }
    SEAM(4);
    if (IN(5)) {
        KARGS();
#pragma unroll 1
        for (int pm = vcu; pm < NTOK / 256; pm += G) {
            int tid = tid_arg; asm volatile("" : "+v"(tid)); const int lane = tid & 63;
            p5_ln1(AIN(0), (const bf16_t*)(ws + WS_BUFB), (const float*)(ws + WS_MODF), AIN(13), AIN(14), (bf16_t*)(ws + WS_X1), (bf16_t*)(ws + WS_BUFA), ws + WS_H2F8, pm, wave, lane);
            VM_WAIT(); __syncthreads(); __builtin_amdgcn_fence(__ATOMIC_ACQUIRE, "agent"); VM_WAIT();
            OneUnit S{(const char*)(ws + WS_BUFA), (const char*)(ws + WS_WR), pm};
            float* logits = outp;
            EpiLogits E{logits};
            pg8::gemm_phase<EpiLogits, OneUnit, false, false>(lds, DM, S, E);
            asm volatile("" : "+v"(tid));
            LAS float* rb = (LAS float*)(misc + 4096); LAS unsigned* hist = (LAS unsigned*)(misc + 5120);
            if (tid < NEXP) { rb[tid] = AIN(16)[tid]; hist[tid] = 0u; }
            VM_WAIT(); __syncthreads(); __builtin_amdgcn_fence(__ATOMIC_ACQUIRE, "agent"); VM_WAIT();
#pragma unroll 1
            for (int half = 0; half < 2; ++half)
                p5_route_quad(logits, (LAS float*)lds, rb, hist, (int*)(ws + WS_AE), (float*)(ws + WS_AW), (int*)(ws + WS_AR), tid, pm * 256 + (half & 1) * 128 + (tid >> 2));
            __syncthreads();
            if (tid < NEXP) ((int*)(ws + WS_CNT))[pm * NEXP + tid] = (int)hist[tid];
            __syncthreads();
        }
    }
    SEAM(5);
    if (IN(6)) { LAUNDER(); (void)lane; p6_phase(ws, misc, bx, G, tid); }
    SEAM(6);
    if (IN(7)) { LAUNDER(); (void)lane;
        const int* tile_e = (const int*)(ws + WS_TILE_E);
        const int T = ((cint_p)tile_e)[4096];
        GateUpOrder S{(const char*)(ws + WS_H2F8), (const char*)(ws + WS_WGU), (const char*)(ws + WS_WSGU), (const int*)(ws + WS_STOK), tile_e, T, G, vcu};
        EpiGateUp E{(char*)outp, nullptr};
        pg8::gemm_phase<EpiGateUp, GateUpOrder, true, true, true>(lds, DM / 2, S, E);
    }
    SEAM(7);
    if (IN(8)) { LAUNDER(); (void)lane;
        const int* tile_e = (const int*)(ws + WS_TILE_E);
        const int T = ((cint_p)tile_e)[4096];
        DownOrder S{(char*)outp, nullptr, (const char*)(ws + WS_WD), (const char*)(ws + WS_WSD), tile_e, (const int*)(ws + WS_SDST), (const float*)(ws + WS_SW), T, G, vcu, 0};
        S.plan();
        EpiDown<false> E{ws + WS_Y, (bf16_t*)(ws + WS_X1), (const float*)(ws + WS_MODF), lds};
        pg8::gemm_phase<EpiDown<false>, DownOrder, true, true, true, true>(lds, EDIM / 2, S, E);
        DownOrder S2 = S; S2.shared = 1; S2.plan();
        EpiDown<true> E2{ws + WS_Y, (bf16_t*)(ws + WS_X1), (const float*)(ws + WS_MODF), lds};
        pg8::gemm_phase<EpiDown<true>, DownOrder, true, true, true, true>(lds, EDIM / 2, S2, E2);
    }
    SEAM(8);
    if (IN(9)) { LAUNDER(); p9_phase(ws + WS_Y, (const int*)(ws + WS_AR), (const bf16_t*)(ws + WS_X1), (const float*)(ws + WS_MODF), AIN(23), AIN(24), outp, gw, NGW, lane); }
#undef IN
#undef SEAM
}

extern "C" void kernel_launch(void* const* d_in, const int* in_sizes, int n_in, void* d_out, int out_size, void* d_ws, size_t ws_size, hipStream_t stream) {
    static int grid = 0;
    if (grid == 0) {
        if (n_in != 26 || in_sizes[0] != NTOK * DM || out_size != NTOK * DM || ws_size < WS_END) {
            fprintf(stderr, "kernel_launch: unexpected problem: n_in %d, in0 %d, out %d, ws %zu (need %zu); nothing launched\n", n_in, n_in > 0 ? in_sizes[0] : -1, out_size, ws_size, (size_t)WS_END); grid = -1; return; }
        int dev = 0, cus = 0, per_cu = 0;
        if (hipGetDevice(&dev) != hipSuccess || hipDeviceGetAttribute(&cus, hipDeviceAttributeMultiprocessorCount, dev) != hipSuccess) { fprintf(stderr, "kernel_launch: device query failed\n"); grid = -1; return; }
        if (hipFuncSetAttribute((const void*)mega_fwd, hipFuncAttributeMaxDynamicSharedMemorySize, LDS_BYTES) != hipSuccess) { fprintf(stderr, "kernel_launch: hipFuncSetAttribute failed\n"); grid = -1; return; }
        if (hipOccupancyMaxActiveBlocksPerMultiprocessor(&per_cu, (const void*)mega_fwd, NWAVES * 64, LDS_BYTES) != hipSuccess || per_cu < 1)
            fprintf(stderr, "kernel_launch: note: occupancy query reports %d workgroups per CU\n", per_cu);
        (void)hipGetLastError();
        grid = cus;
    }
    if (grid < 0) return;
    if (hipMemsetAsync((char*)d_ws + WS_CTL, 0, CTL_ZERO_BYTES, stream) != hipSuccess) { fprintf(stderr, "kernel_launch: memset failed\n"); return; }
    Args a{};
    for (int i = 0; i < 26; ++i) a.in[i] = (const float*)d_in[i];
    a.out = (float*)d_out; a.ws = (unsigned char*)d_ws;
    if (MK_N_LAUNCHES == 1) {
        a.ph_lo = 0; a.ph_hi = N_PHASES;
        hipLaunchKernelGGL(mega_fwd, dim3(grid), dim3(NWAVES * 64), LDS_BYTES, stream, a);
    } else {
        for (int p = 0; p < N_PHASES; ++p) { a.ph_lo = p; a.ph_hi = p + 1; hipLaunchKernelGGL(mega_fwd, dim3(grid), dim3(NWAVES * 64), LDS_BYTES, stream, a); }
    }
    const hipError_t le = hipPeekAtLastError();
    if (le != hipSuccess) fprintf(stderr, "kernel_launch: launch failed: %s\n", hipGetErrorName(le));
}
```
